# Optimizing an MI355X kernel written in HIP

```python
import jax, jax.numpy as jnp
from jax import lax
import numpy as np

D_MODEL = 1024
BATCH = 4
SEQ = 4096
DEPTH = 2

HEAD_DIM = 64
BLOCK = 128
ROPE_THETA = 10000.0
EPS = 1e-6
A_HEADS = 8
IDX_HEADS = 4
IDX_DIM = 64
TOPK_MAX = 256
B_Q_HEADS = 8
B_KV_HEADS = 2
WINDOW = 128
C_HEADS = 8

A_WIDTH = A_HEADS * HEAD_DIM
B_WIDTH = B_Q_HEADS * HEAD_DIM
B_KV_WIDTH = B_KV_HEADS * HEAD_DIM
C_WIDTH = C_HEADS * HEAD_DIM

SPLIT_SIZES = (
    A_WIDTH, A_WIDTH, A_WIDTH, A_WIDTH,
    IDX_HEADS * IDX_DIM, IDX_DIM, IDX_HEADS,
    B_WIDTH, B_KV_WIDTH, B_KV_WIDTH, B_WIDTH,
    C_WIDTH, C_WIDTH, C_WIDTH, C_WIDTH,
    D_MODEL, D_MODEL, D_MODEL,
)
D_IN = int(sum(SPLIT_SIZES))
SPLIT_OFFSETS = [int(o) for o in np.cumsum(SPLIT_SIZES)[:-1]]

kernel_name = "hybrid_dsa_swa_stickbreak_gated_trunk"


def rms_norm(x, g):
    xf = x.astype(jnp.float32)
    y = xf * lax.rsqrt(jnp.mean(xf * xf, axis=-1, keepdims=True) + EPS)
    return (y * g.astype(jnp.float32)).astype(x.dtype)


def rope_tables(seq, dim):
    inv = 1.0 / (ROPE_THETA ** (jnp.arange(0, dim, 2, dtype=jnp.float32) / dim))
    ang = jnp.arange(seq, dtype=jnp.float32)[:, None] * inv[None, :]
    return jnp.cos(ang), jnp.sin(ang)


def apply_rope(x, cos, sin):
    x1, x2 = jnp.split(x.astype(jnp.float32), 2, axis=-1)
    c = cos[None, :, None, :]
    s = sin[None, :, None, :]
    return jnp.concatenate([x1 * c - x2 * s, x1 * s + x2 * c], axis=-1).astype(x.dtype)


def dsa_attention(q, k, v, iq, ik, iw):
    bsz, seq, n_heads, dh = q.shape
    topk = min(TOPK_MAX, seq // 4)
    n_blocks = seq // BLOCK
    key_pos = jnp.arange(seq)
    w_scale = (IDX_HEADS ** -0.5) * (IDX_DIM ** -0.5)
    ikf = ik.astype(jnp.float32)

    def block(i):
        t0 = i * BLOCK
        qb = lax.dynamic_slice_in_dim(q, t0, BLOCK, axis=1)
        iqb = lax.dynamic_slice_in_dim(iq, t0, BLOCK, axis=1).astype(jnp.float32)
        iwb = lax.dynamic_slice_in_dim(iw, t0, BLOCK, axis=1).astype(jnp.float32)
        qpos = t0 + jnp.arange(BLOCK)
        causal = key_pos[None, :] <= qpos[:, None]
        dots = jnp.einsum('bthd,bsd->bths', iqb, ikf)
        score = jnp.einsum('bth,bths->bts', iwb * w_scale, jax.nn.relu(dots))
        score = jnp.where(causal[None], score, -jnp.inf)
        top_val, top_idx = lax.top_k(score, topk)
        valid = jnp.isfinite(top_val)
        k_sel = jax.vmap(lambda kk, ii: kk[ii])(k, top_idx)
        v_sel = jax.vmap(lambda vv, ii: vv[ii])(v, top_idx)
        logits = jnp.einsum('bthd,btkhd->bhtk', qb, k_sel).astype(jnp.float32) * (dh ** -0.5)
        logits = jnp.where(valid[:, None], logits, -jnp.inf)
        p = jax.nn.softmax(logits, axis=-1)
        return jnp.einsum('bhtk,btkhd->bthd', p.astype(v.dtype), v_sel)

    out = lax.map(block, jnp.arange(n_blocks))
    return out.transpose(1, 0, 2, 3, 4).reshape(bsz, seq, n_heads, dh)


def swa_sinks_attention(q, k, v, sinks):
    bsz, seq, hq, dh = q.shape
    hkv = k.shape[2]
    grp = hq // hkv
    nb = seq // BLOCK
    qb = q.reshape(bsz, nb, BLOCK, hkv, grp, dh)

    def band(t):
        tb = t.reshape(bsz, nb, BLOCK, hkv, dh)
        prev = jnp.concatenate([jnp.zeros_like(tb[:, :1]), tb[:, :-1]], axis=1)
        return jnp.concatenate([prev, tb], axis=2)

    kb, vb = band(k), band(v)
    logits = jnp.einsum('bnqhgd,bnkhd->bnhgqk', qb, kb).astype(jnp.float32) * (dh ** -0.5)
    blk = jnp.arange(nb)[:, None, None]
    qpos = blk * BLOCK + jnp.arange(BLOCK)[None, :, None]
    kpos = blk * BLOCK - BLOCK + jnp.arange(2 * BLOCK)[None, None, :]
    allowed = (kpos <= qpos) & (kpos > qpos - WINDOW) & (kpos >= 0)
    logits = jnp.where(allowed[None, :, None, None], logits, -jnp.inf)
    sink = jnp.broadcast_to(
        sinks.astype(jnp.float32).reshape(hkv, grp)[None, None, :, :, None, None],
        logits.shape[:-1] + (1,))
    p = jax.nn.softmax(jnp.concatenate([logits, sink], axis=-1), axis=-1)[..., :-1]
    out = jnp.einsum('bnhgqk,bnkhd->bnqhgd', p.astype(v.dtype), vb)
    return out.reshape(bsz, seq, hq, dh)


def stick_breaking_attention(q, k, v):
    bsz, seq, n_heads, dh = q.shape
    nb = seq // BLOCK
    key_pos = jnp.arange(seq)

    def block(i):
        t0 = i * BLOCK
        qb = lax.dynamic_slice_in_dim(q, t0, BLOCK, axis=1)
        qpos = t0 + jnp.arange(BLOCK)
        strict = (key_pos[None, :] < qpos[:, None])[None, None]
        z = jnp.einsum('bthd,bshd->bhts', qb, k).astype(jnp.float32) * (dh ** -0.5)
        log_beta = jax.nn.log_sigmoid(z)
        log_1m = jnp.where(strict, jax.nn.log_sigmoid(-z), 0.0)
        after = lax.cumsum(log_1m, axis=3, reverse=True) - log_1m
        a = jnp.where(strict, jnp.exp(log_beta + after), 0.0)
        return jnp.einsum('bhts,bshd->bthd', a.astype(v.dtype), v)

    out = lax.map(block, jnp.arange(nb))
    return out.transpose(1, 0, 2, 3, 4).reshape(bsz, seq, n_heads, dh)


def hybrid_layer(x, c_silu, cos, sin, norm_g, w_ada, b_ada, w_in, sinks, w_br_a, w_br_b, w_br_c, w_out):
    bsz, seq, _ = x.shape
    mod = c_silu @ w_ada + b_ada
    shift, scale, gate = jnp.split(mod, 3, axis=-1)
    u = rms_norm(x, norm_g) * (1 + scale[:, None]) + shift[:, None]
    z = u @ w_in
    (aq, ak, av, ag, iq, ik, iw, bq, bk, bv, bg, cq, ck, cv, cg, ma, mb, mc) = jnp.split(z, SPLIT_OFFSETS, axis=-1)

    def heads(t, n):
        return t.reshape(bsz, seq, n, -1)

    ya = dsa_attention(
        apply_rope(heads(aq, A_HEADS), cos, sin),
        apply_rope(heads(ak, A_HEADS), cos, sin),
        heads(av, A_HEADS),
        apply_rope(heads(iq, IDX_HEADS), cos, sin),
        apply_rope(ik[:, :, None, :], cos, sin)[:, :, 0, :],
        iw)
    ya = ya.reshape(bsz, seq, A_WIDTH) * jax.nn.silu(ag)
    yb = swa_sinks_attention(
        apply_rope(heads(bq, B_Q_HEADS), cos, sin),
        apply_rope(heads(bk, B_KV_HEADS), cos, sin),
        heads(bv, B_KV_HEADS),
        sinks)
    yb = yb.reshape(bsz, seq, B_WIDTH) * jax.nn.silu(bg)
    yc = stick_breaking_attention(heads(cq, C_HEADS), heads(ck, C_HEADS), heads(cv, C_HEADS))
    yc = yc.reshape(bsz, seq, C_WIDTH) * jax.nn.silu(cg)

    merged = (jax.nn.sigmoid(ma) * (ya @ w_br_a)
              + jax.nn.sigmoid(mb) * (yb @ w_br_b)
              + jax.nn.sigmoid(mc) * (yc @ w_br_c))
    return x + gate[:, None] * (merged @ w_out)


def setup_inputs(seed: int = 0) -> dict:
    key = jax.random.key(seed)
    ks = jax.random.split(key, 13)
    f32 = jnp.float32

    def nrm(k, shape, scale):
        return jax.random.normal(k, shape, dtype=f32) * scale

    return {
        "x": nrm(ks[0], (BATCH, SEQ, D_MODEL), 1.0),
        "c": nrm(ks[1], (BATCH, D_MODEL), 1.0),
        "norm_g": 1.0 + nrm(ks[2], (DEPTH, D_MODEL), 0.02),
        "w_ada": nrm(ks[3], (DEPTH, D_MODEL, 3 * D_MODEL), 0.2 * D_MODEL ** -0.5),
        "b_ada": nrm(ks[4], (DEPTH, 3 * D_MODEL), 0.02),
        "w_in": nrm(ks[5], (DEPTH, D_MODEL, D_IN), D_MODEL ** -0.5),
        "sinks": nrm(ks[6], (DEPTH, B_Q_HEADS), 0.5),
        "w_br_a": nrm(ks[7], (DEPTH, A_WIDTH, D_MODEL), A_WIDTH ** -0.5),
        "w_br_b": nrm(ks[8], (DEPTH, B_WIDTH, D_MODEL), B_WIDTH ** -0.5),
        "w_br_c": nrm(ks[9], (DEPTH, C_WIDTH, D_MODEL), C_WIDTH ** -0.5),
        "w_out": nrm(ks[10], (DEPTH, D_MODEL, D_MODEL), D_MODEL ** -0.5),
        "final_g": 1.0 + nrm(ks[11], (D_MODEL,), 0.02),
    }


def reference(x, c, norm_g, w_ada, b_ada, w_in, sinks, w_br_a, w_br_b, w_br_c, w_out, final_g):
    seq = x.shape[1]
    cos, sin = rope_tables(seq, HEAD_DIM)
    c_silu = jax.nn.silu(c)
    h = x
    for l in range(DEPTH):
        h = hybrid_layer(h, c_silu, cos, sin, norm_g[l], w_ada[l], b_ada[l], w_in[l], sinks[l],
                         w_br_a[l], w_br_b[l], w_br_c[l], w_out[l])
    return rms_norm(h, final_g)
```

```cpp
#include <hip/hip_runtime.h>
#include <hip/hip_cooperative_groups.h>
#include <cstdio>
#include <cstdint>
namespace cg = cooperative_groups;

#ifndef SCORE_REP
#define SCORE_REP 1
#define SEL_REP 1
#endif
#ifndef ATT_REP_A
#define ATT_REP_A 1
#define ATT_REP_B 1
#define ATT_REP_C 1
#endif
#ifndef REP_LO
#define REP_LO -1
#define REP_HI -1
#endif
#ifndef USE_COOP
#define USE_COOP 1
#endif

typedef unsigned short bf16_t;
using bf16x8 = __attribute__((ext_vector_type(8))) short;
using f32x4 = __attribute__((ext_vector_type(4))) float;
using f32x16 = __attribute__((ext_vector_type(16))) float;
typedef float f32x2 __attribute__((ext_vector_type(2)));
typedef unsigned u32x4 __attribute__((ext_vector_type(4)));
typedef __bf16 nbf16x2 __attribute__((ext_vector_type(2)));
#define DI __device__ __forceinline__
DI int opaque_tid() { int t = threadIdx.x; asm volatile("" : "+v"(t)); return t; }

constexpr int DM = 1024, NBATCH = 4, SEQ = 4096, NTOK = NBATCH * SEQ, DIN = 8772;
constexpr int NT32 = SEQ / 32;
constexpr int WT_IN_ROWS = 8960;
constexpr int COL_IDX = 5376, COL_GATE = 5888;
constexpr int LDS_BYTES = 131072 + 16;
constexpr float C2 = 0.125f * 1.4426950408889634f;
constexpr float LOG2E = 1.4426950408889634f;

struct Params {
  const float *x, *c, *norm_g, *w_ada, *w_br_a, *b_ada, *w_br_b, *w_in, *sinks, *w_out, *w_br_c, *final_g;
  float* out;
  float2* rope;
  float* mod;
  bf16_t* u;
  bf16_t* wt_in;
  bf16_t* wt_br;
  bf16_t* wt_out;
  bf16_t *zAq, *zAk, *zAv, *zAg;
  bf16_t *zBq, *zBk, *zBv, *zBg;
  bf16_t *zCq, *zCk, *zCv, *zCg;
  bf16_t *iq, *ik;
  float* iw;
  unsigned* bitmask;
  float* sscr;
  bf16_t* merged;
  bf16_t* sigscr;
};

DI unsigned pk2(float a, float b) { f32x2 v = {a, b}; nbf16x2 r = __builtin_convertvector(v, nbf16x2); return __builtin_bit_cast(unsigned, r); }
DI float bf2f(bf16_t h) { return __uint_as_float(((unsigned)h) << 16); }
DI float wave_sum(float v) {
#pragma unroll
  for (int o = 32; o >= 1; o >>= 1) v += __shfl_xor(v, o);
  return v;
}
DI float fsigmoid(float x) { return __builtin_amdgcn_rcpf(1.0f + __builtin_amdgcn_exp2f(-1.4426950408889634f * x)); }

constexpr int BM = 256, BK = 64, HALF = 128, HT = HALF * BK;
DI int lds_byte(int r, int c) { int st = (r >> 4) * 2 + (c >> 5), rr = r & 15, cc = c & 31, ob = rr * 64 + cc * 2; return st * 1024 + (ob ^ (((ob >> 9) & 1) << 5)); }
DI void stage_rc(int b, int& R, int& C) { int st = b / 1024, sb = b % 1024, swz = sb ^ (((sb >> 9) & 1) << 5); R = (st >> 1) * 16 + swz / 64; C = (st & 1) * 32 + (swz % 64) / 2; }

#define LAS __attribute__((address_space(3)))
constexpr int HTB = HT * 2;
struct GemmTile { const bf16_t* A; const bf16_t* Bt; int K, brow, bcol; };
DI void gemm_prologue(const GemmTile g, LAS unsigned char* lds) {
  const int tid = opaque_tid(), wid = __builtin_amdgcn_readfirstlane(tid >> 6);
  const int K = g.K;
  unsigned voff[2];
#pragma unroll
  for (int i = 0; i < 2; ++i) { int R, C; stage_rc(tid * 16 + i * 8192, R, C); voff[i] = (unsigned)(R * K + C) * 2u; }
  const size_t kstep = (size_t)(BK * 2), hstep = (size_t)HALF * K * 2;
  const char* a0 = (const char*)(g.A + (size_t)g.brow * K);
  const char* b0 = (const char*)(g.Bt + (size_t)g.bcol * K);
  const unsigned ldsw = (unsigned)wid * 1024u;
#define SA(b, h) (((b)*2 + (h)) * HTB)
#define SB(b, h) ((4 + (b)*2 + (h)) * HTB)
#define STAGE(bufoff, gbase) do { _Pragma("unroll") for (int _i = 0; _i < 2; ++_i) \
    __builtin_amdgcn_global_load_lds((const unsigned*)((const char*)(gbase) + voff[_i]), (LAS unsigned*)(lds + (bufoff) + ldsw + _i * 8192), 16, 0, 0); } while (0)
  STAGE(SB(0, 0), b0); STAGE(SA(0, 0), a0);
  STAGE(SB(0, 1), b0 + hstep); STAGE(SA(0, 1), a0 + hstep);
  STAGE(SB(1, 0), b0 + kstep); STAGE(SA(1, 0), a0 + kstep); STAGE(SB(1, 1), b0 + hstep + kstep);
#undef SA
#undef SB
#undef STAGE
}
template <bool PER_M, class Epi>
DI void gemm256(const GemmTile g, const bool has_next, const GemmTile gn, LAS unsigned char* lds, Epi epi) {
  const bf16_t* __restrict__ A = g.A; const bf16_t* __restrict__ Bt = g.Bt; const int K = g.K, brow = g.brow, bcol = g.bcol;
  asm volatile("s_waitcnt vmcnt(0) lgkmcnt(0)" ::: "memory");
  __syncthreads();
  const int tid = opaque_tid(), wid = __builtin_amdgcn_readfirstlane(tid >> 6), lane = tid & 63, wr = wid >> 2, wc = wid & 3, fr = lane & 15, fq = lane >> 4;
  const int nt = K / BK;
  unsigned voff[2];
#pragma unroll
  for (int i = 0; i < 2; ++i) { int R, C; stage_rc(tid * 16 + i * 8192, R, C); voff[i] = (unsigned)(R * K + C) * 2u; }
  const size_t kstep = (size_t)(BK * 2), hstep = (size_t)HALF * K * 2;
  const char* a0 = (const char*)(A + (size_t)brow * K);
  const char* b0 = (const char*)(Bt + (size_t)bcol * K);
  const unsigned ldsw = (unsigned)wid * 1024u;
  const int aoff = lds_byte(wr * 64 + fr, fq * 8), boff = lds_byte(wc * 32 + fr, fq * 8);
#define SA(b, h) (((b)*2 + (h)) * HTB)
#define SB(b, h) ((4 + (b)*2 + (h)) * HTB)
#define STAGE(bufoff, gbase) do { _Pragma("unroll") for (int _i = 0; _i < 2; ++_i) \
    __builtin_amdgcn_global_load_lds((const unsigned*)((const char*)(gbase) + voff[_i]), (LAS unsigned*)(lds + (bufoff) + ldsw + _i * 8192), 16, 0, 0); } while (0)
#define LDA(dst, b, h) do { _Pragma("unroll") for (int m = 0; m < 4; ++m) _Pragma("unroll") for (int k = 0; k < 2; ++k) dst[m][k] = *(const LAS bf16x8*)(lds + SA(b, h) + aoff + m * 2048 + k * 1024); } while (0)
#define LDB(dst, b, h) do { _Pragma("unroll") for (int n = 0; n < 2; ++n) _Pragma("unroll") for (int k = 0; k < 2; ++k) dst[n][k] = *(const LAS bf16x8*)(lds + SB(b, h) + boff + n * 2048 + k * 1024); } while (0)
#define MMA(ai, bj, At_, Bt_) do { __builtin_amdgcn_s_setprio(1); _Pragma("unroll") for (int m = 0; m < 4; ++m) _Pragma("unroll") for (int n = 0; n < 2; ++n) _Pragma("unroll") for (int k = 0; k < 2; ++k) \
      acc[ai][bj][m][n] = __builtin_amdgcn_mfma_f32_16x16x32_bf16(Bt_[n][k], At_[m][k], acc[ai][bj][m][n], 0, 0, 0); \
    __builtin_amdgcn_s_setprio(0); } while (0)
#define WAIT_V(n) asm volatile("s_waitcnt vmcnt(" #n ")" ::: "memory")
#define WAIT_L(n) asm volatile("s_waitcnt lgkmcnt(" #n ")" ::: "memory")
#define BAR __builtin_amdgcn_s_barrier()
#define SCHED __builtin_amdgcn_sched_barrier(0)
  f32x4 acc[2][2][4][2];
#pragma unroll
  for (int a = 0; a < 2; ++a)
#pragma unroll
    for (int b = 0; b < 2; ++b)
#pragma unroll
      for (int m = 0; m < 4; ++m)
#pragma unroll
        for (int n = 0; n < 2; ++n) acc[a][b][m][n] = (f32x4){0.f, 0.f, 0.f, 0.f};
  bf16x8 At[4][2], B0[2][2], B1[2][2];
  if (wr == 1) BAR;
  BAR;
  BAR;
  for (int t = 0; t < nt - 2; t += 2) {
    const char* a1 = a0 + (size_t)(t + 1) * kstep; const char* a2 = a1 + kstep; const char* a3 = a2 + kstep;
    const char* b2 = b0 + (size_t)(t + 2) * kstep; const char* b3 = b2 + kstep;
    LDB(B0, 0, 0); SCHED; LDA(At, 0, 0); STAGE(SA(1, 1), a1 + hstep);
    WAIT_L(8); BAR; WAIT_L(0); MMA(0, 0, At, B0); BAR; SCHED;
    LDB(B1, 0, 1); STAGE(SB(0, 0), b2);
    BAR; WAIT_L(0); MMA(0, 1, At, B1); BAR;
    LDA(At, 0, 1); STAGE(SA(0, 0), a2);
    BAR; WAIT_L(0); MMA(1, 0, At, B0); BAR; SCHED;
    STAGE(SB(0, 1), b2 + hstep);
    WAIT_V(6); BAR; MMA(1, 1, At, B1); BAR;
    LDB(B0, 1, 0); SCHED; LDA(At, 1, 0); STAGE(SA(0, 1), a2 + hstep);
    WAIT_L(8); BAR; WAIT_L(0); MMA(0, 0, At, B0); BAR; SCHED;
    LDB(B1, 1, 1); STAGE(SB(1, 0), b3);
    BAR; WAIT_L(0); MMA(0, 1, At, B1); BAR;
    LDA(At, 1, 1); STAGE(SA(1, 0), a3);
    BAR; WAIT_L(0); MMA(1, 0, At, B0); BAR; SCHED;
    STAGE(SB(1, 1), b3 + hstep);
    WAIT_V(6); BAR; MMA(1, 1, At, B1); BAR;
  }
  { LDB(B0, 0, 0); LDA(At, 0, 0); STAGE(SA(1, 1), a0 + (size_t)(nt - 1) * kstep + hstep);
    BAR; WAIT_L(0); MMA(0, 0, At, B0); BAR;
    LDB(B1, 0, 1); BAR; WAIT_L(0); MMA(0, 1, At, B1); BAR;
    LDA(At, 0, 1); WAIT_V(4); BAR; WAIT_L(0); MMA(1, 0, At, B0); MMA(1, 1, At, B1); BAR; }
  { LDB(B0, 1, 0); LDA(At, 1, 0); WAIT_V(2); BAR; WAIT_L(0); MMA(0, 0, At, B0); BAR;
    LDB(B1, 1, 1); WAIT_V(0); BAR; WAIT_L(0); MMA(0, 1, At, B1); BAR;
    LDA(At, 1, 1); BAR; WAIT_L(0); MMA(1, 0, At, B0); MMA(1, 1, At, B1); BAR; }
  if (wr == 0) BAR;
  if (has_next) gemm_prologue(gn, lds);
  {
    int tid2 = opaque_tid();
    int wid2 = __builtin_amdgcn_readfirstlane(tid2 >> 6);
    const int lane2 = tid2 & 63, wr2 = wid2 >> 2, wc2 = wid2 & 3, fr2 = lane2 & 15, fq2 = lane2 >> 4;
#pragma unroll
    for (int ai = 0; ai < 2; ++ai)
#pragma unroll
      for (int bj = 0; bj < 2; ++bj) {
        if constexpr (PER_M) {
#pragma unroll
          for (int m = 0; m < 4; ++m) epi(ai, bj, m, acc[ai][bj][m][0], acc[ai][bj][m][1], tid2, wr2, wc2, fr2, fq2);
        } else {
          epi(ai, bj, acc[ai][bj], tid2, wr2, wc2, fr2, fq2);
        }
        SCHED;
      }
  }
#undef SA
#undef SB
#undef STAGE
#undef LDA
#undef LDB
#undef MMA
}

DI void rope4(f32x4& a, f32x4& b, const float2* __restrict__ tab, int pos, int d0) {
  const f32x4* tp = (const f32x4*)(tab + pos * 32 + d0);
  f32x4 t0 = tp[0], t1 = tp[1];
  float cs[4] = {t0[0], t0[2], t1[0], t1[2]}, sn[4] = {t0[1], t0[3], t1[1], t1[3]};
#pragma unroll
  for (int j = 0; j < 4; ++j) { float x1 = a[j], x2 = b[j]; a[j] = x1 * cs[j] - x2 * sn[j]; b[j] = x1 * sn[j] + x2 * cs[j]; }
}
DI void st4bf(bf16_t* p, f32x4 v) { uint2 w; w.x = pk2(v[0], v[1]); w.y = pk2(v[2], v[3]); *(uint2*)p = w; }
DI size_t kfrag_off(int bh, int pos, int d) { return ((size_t)bh * NT32 + (pos >> 5)) * 2048 + (size_t)(((d >> 4) * 64 + (pos & 31) + 32 * ((d >> 3) & 1)) * 8 + (d & 7)); }
DI size_t vfrag_off(int bh, int pos, int d) {
  int k32 = pos & 31, s = k32 >> 4, hi = (k32 >> 2) & 1, jj = ((k32 >> 3) & 1) * 4 + (k32 & 3);
  return ((size_t)bh * NT32 + (pos >> 5)) * 2048 + (size_t)((((d >> 5) * 2 + s) * 64 + (d & 31) + 32 * hi) * 8 + jj);
}
DI void st_vfrag(bf16_t* base, int bh, int pos, int d0, f32x4 v) {
  bf16_t* o = base + vfrag_off(bh, pos, d0);
  const unsigned w0 = pk2(v[0], v[1]), w1 = pk2(v[2], v[3]);
  o[0] = (bf16_t)(w0 & 0xffff); o[8] = (bf16_t)(w0 >> 16); o[16] = (bf16_t)(w1 & 0xffff); o[24] = (bf16_t)(w1 >> 16);
}
DI void st_vfrag2(bf16_t* o, f32x4 v) {
  const unsigned w0 = pk2(v[0], v[1]), w1 = pk2(v[2], v[3]);
  o[0] = (bf16_t)(w0 & 0xffff); o[8] = (bf16_t)(w0 >> 16); o[16] = (bf16_t)(w1 & 0xffff); o[24] = (bf16_t)(w1 >> 16);
}
DI f32x4 silu4(f32x4 v) { f32x4 r; for (int j = 0; j < 4; ++j) r[j] = v[j] * fsigmoid(v[j]); return r; }

DI void epi_main(const Params& p, int row, int G, int dlo, f32x4 v0, f32x4 v1) {
  const int b = row >> 12, pos = row & (SEQ - 1);
  if (G < 8) { rope4(v0, v1, p.rope, pos, dlo); bf16_t* o = p.zAq + (size_t)row * 512 + G * 64 + dlo; st4bf(o, v0); st4bf(o + 32, v1); }
  else if (G < 16) { rope4(v0, v1, p.rope, pos, dlo); int bh = b * 8 + (G - 8); { bf16_t* o = p.zAk + kfrag_off(bh, pos, dlo); st4bf(o, v0); st4bf(o + 1024, v1); } }
  else if (G < 24) { int bh = b * 8 + (G - 16); { bf16_t* o = p.zAv + vfrag_off(bh, pos, dlo); st_vfrag2(o, v0); st_vfrag2(o + 1024, v1); } }
  else if (G < 32) { bf16_t* o = p.zAg + (size_t)row * 512 + (G - 24) * 64 + dlo; st4bf(o, silu4(v0)); st4bf(o + 32, silu4(v1)); }
  else if (G < 40) { rope4(v0, v1, p.rope, pos, dlo); bf16_t* o = p.zBq + (size_t)row * 512 + (G - 32) * 64 + dlo; st4bf(o, v0); st4bf(o + 32, v1); }
  else if (G < 42) { rope4(v0, v1, p.rope, pos, dlo); int bh = b * 2 + (G - 40); { bf16_t* o = p.zBk + kfrag_off(bh, pos, dlo); st4bf(o, v0); st4bf(o + 1024, v1); } }
  else if (G < 44) { int bh = b * 2 + (G - 42); { bf16_t* o = p.zBv + vfrag_off(bh, pos, dlo); st_vfrag2(o, v0); st_vfrag2(o + 1024, v1); } }
  else if (G < 52) { bf16_t* o = p.zBg + (size_t)row * 512 + (G - 44) * 64 + dlo; st4bf(o, silu4(v0)); st4bf(o + 32, silu4(v1)); }
  else if (G < 60) { bf16_t* o = p.zCq + (size_t)row * 512 + (G - 52) * 64 + dlo; st4bf(o, v0); st4bf(o + 32, v1); }
  else if (G < 68) { int bh = b * 8 + (G - 60); { bf16_t* o = p.zCk + kfrag_off(bh, pos, dlo); st4bf(o, v0); st4bf(o + 1024, v1); } }
  else if (G < 76) { int bh = b * 8 + (G - 68); { bf16_t* o = p.zCv + vfrag_off(bh, pos, dlo); st_vfrag2(o, v0); st_vfrag2(o + 1024, v1); } }
  else { bf16_t* o = p.zCg + (size_t)row * 512 + (G - 76) * 64 + dlo; st4bf(o, silu4(v0)); st4bf(o + 32, silu4(v1)); }
}
DI void epi_idx(const Params& p, int row, int G, int dlo, f32x4 v0, f32x4 v1) {
  const int pos = row & (SEQ - 1);
  if (G < 4) { rope4(v0, v1, p.rope, pos, dlo); bf16_t* o = p.iq + (size_t)row * 256 + G * 64 + dlo; st4bf(o, v0); st4bf(o + 32, v1); }
  else if (G == 4) { rope4(v0, v1, p.rope, pos, dlo); bf16_t* o = p.ik + (size_t)row * 64 + dlo; st4bf(o, v0); st4bf(o + 32, v1); }
  else if (G == 5 && dlo == 0) { *(f32x4*)(p.iw + (size_t)row * 4) = v0 * 0.0625f; }
}

DI void phase_prep(const Params& p, char* lds) {
  const int tid = opaque_tid();
  for (int i = blockIdx.x * 512 + tid; i < SEQ * 32; i += gridDim.x * 512) {
    int pos = i >> 5, d = i & 31;
    float inv = 1.0f / powf(10000.0f, (float)d / 32.0f);
    float ang = (float)pos * inv;
    double xr = (double)ang * 0.15915494309189535; double fr = xr - rint(xr); float f = (float)fr;
    p.rope[i] = make_float2(__builtin_amdgcn_cosf(f), __builtin_amdgcn_sinf(f));
  }
  float* sl = (float*)lds; float* red = sl + 4096;
  for (int i = tid; i < 4096; i += 512) { float c = p.c[i]; sl[i] = c / (1.0f + expf(-c)); }
  __syncthreads();
  for (int unit = blockIdx.x; unit < 192; unit += gridDim.x) {
    const int l = unit / 96, n0 = (unit % 96) * 32, cn = tid & 31, kg = __builtin_amdgcn_readfirstlane(tid >> 6) * 2 + ((tid >> 5) & 1);
    const float* w = p.w_ada + (size_t)l * 1024 * 3072 + n0 + cn;
    float a0 = 0, a1 = 0, a2 = 0, a3 = 0;
    for (int k0 = kg * 64; k0 < kg * 64 + 64; k0 += 16) {
      float wv[16];
#pragma unroll
      for (int j = 0; j < 16; ++j) wv[j] = w[(size_t)(k0 + j) * 3072];
#pragma unroll
      for (int j = 0; j < 16; ++j) { a0 += sl[k0 + j] * wv[j]; a1 += sl[1024 + k0 + j] * wv[j]; a2 += sl[2048 + k0 + j] * wv[j]; a3 += sl[3072 + k0 + j] * wv[j]; }
    }
    red[(kg * 4 + 0) * 32 + cn] = a0; red[(kg * 4 + 1) * 32 + cn] = a1; red[(kg * 4 + 2) * 32 + cn] = a2; red[(kg * 4 + 3) * 32 + cn] = a3;
    __syncthreads();
    if (tid < 128) { const int b = tid >> 5; float sm = 0; for (int g = 0; g < 16; ++g) sm += red[(g * 4 + b) * 32 + cn]; p.mod[(l * 4 + b) * 3072 + n0 + cn] = sm + p.b_ada[l * 3072 + n0 + cn]; }
    __syncthreads();
  }
}

DI int wt_in_src_col(int np) {
  if (np >= COL_GATE) return np - COL_GATE + 5700;
  int c64 = np & 63; int d = ((c64 >> 5) & 1) * 16 + (c64 & 15) + ((c64 >> 4) & 1) * 32; int L = (np & ~63) + d;
  if (L < 2048) return L;
  if (L < COL_IDX) return L + 324;
  int q = L - COL_IDX; return q < 324 ? 2048 + q : -1;
}
struct WtTile { const float* src; bf16_t* dst; int lds_src, K, np0, k0, mode; };
DI WtTile wt_decode(const Params& p, int l, int t) {
  WtTile w;
  if (t < 1120) { w.k0 = (t & 7) * 128; w.np0 = (t >> 3) * 64; w.src = p.w_in + (size_t)l * 1024 * DIN; w.lds_src = DIN; w.K = 1024; w.dst = p.wt_in; w.mode = 0; }
  else if (t < 1312) { const int q = t - 1120, x = q >> 6, r = q & 63; w.k0 = (r & 3) * 128; w.np0 = (r >> 2) * 64;
    const float* wa_ = p.w_br_a; const float* wb_ = p.w_br_b; const float* wc_ = p.w_br_c; asm volatile("" : "+s"(wa_), "+s"(wb_), "+s"(wc_));
    const float* wb = x == 0 ? wa_ : (x == 1 ? wb_ : wc_); w.src = wb + (size_t)l * 512 * 1024; w.lds_src = 1024; w.K = 512; w.dst = p.wt_br + (size_t)x * 1024 * 512; w.mode = 1; }
  else { const int q = t - 1312; w.k0 = (q & 7) * 128; w.np0 = (q >> 3) * 64; w.src = p.w_out + (size_t)l * 1024 * 1024; w.lds_src = 1024; w.K = 1024; w.dst = p.wt_out; w.mode = 1; }
  return w;
}
DI void phase_a(const Params& p, int l, const float* xin, char* lds) {
  const int tid = opaque_tid(), lane = tid & 63, wave = __builtin_amdgcn_readfirstlane(tid >> 6);
  for (int row0 = (blockIdx.x * 8 + wave) * 4; row0 < NTOK; row0 += gridDim.x * 32) {
    f32x4 v[4][4]; float ss[4] = {0.f, 0.f, 0.f, 0.f};
#pragma unroll
    for (int r = 0; r < 4; ++r)
#pragma unroll
      for (int i = 0; i < 4; ++i) v[r][i] = *(const f32x4*)(xin + (size_t)(row0 + r) * 1024 + i * 256 + lane * 4);
    const int b = row0 >> 12;
    const float* md = p.mod + (l * 4 + b) * 3072;
    f32x4 gg[4], shh[4], scc[4];
#pragma unroll
    for (int i = 0; i < 4; ++i) { const int col = i * 256 + lane * 4; gg[i] = *(const f32x4*)(p.norm_g + l * 1024 + col); shh[i] = *(const f32x4*)(md + col); scc[i] = *(const f32x4*)(md + 1024 + col); }
#pragma unroll
    for (int r = 0; r < 4; ++r) {
#pragma unroll
      for (int i = 0; i < 4; ++i) ss[r] += v[r][i][0] * v[r][i][0] + v[r][i][1] * v[r][i][1] + v[r][i][2] * v[r][i][2] + v[r][i][3] * v[r][i][3];
      ss[r] = wave_sum(ss[r]);
    }
#pragma unroll
    for (int i = 0; i < 4; ++i) {
      int col = i * 256 + lane * 4;
      const f32x4 g = gg[i], sh = shh[i], sc = scc[i];
#pragma unroll
      for (int r = 0; r < 4; ++r) {
        const float rstd = rsqrtf(ss[r] * (1.0f / 1024.0f) + 1e-6f);
        f32x4 uu; for (int j = 0; j < 4; ++j) uu[j] = v[r][i][j] * rstd * g[j] * (1.0f + sc[j]) + sh[j];
        st4bf(p.u + (size_t)(row0 + r) * 1024 + col, uu);
      }
    }
  }
  float* tile = (float*)lds;
  const int kk = tid >> 4, c4 = (tid & 15) * 4;
  f32x4 val[4];
  int t = blockIdx.x;
  if (t < 1440) { WtTile w = wt_decode(p, l, t); const int ncol = w.mode == 0 ? wt_in_src_col(w.np0 + c4) : w.np0 + c4;
#pragma unroll
    for (int it = 0; it < 4; ++it) { val[it] = (f32x4){0.f, 0.f, 0.f, 0.f}; if (ncol >= 0) val[it] = *(const f32x4*)(w.src + (size_t)(w.k0 + kk + it * 32) * w.lds_src + ncol); } }
  for (; t < 1440; t += gridDim.x) {
    const WtTile w = wt_decode(p, l, t);
    f32x4 nval[4];
    const int tn = t + gridDim.x;
    if (tn < 1440) { const WtTile wn = wt_decode(p, l, tn); const int ncoln = wn.mode == 0 ? wt_in_src_col(wn.np0 + c4) : wn.np0 + c4;
#pragma unroll
      for (int it = 0; it < 4; ++it) { nval[it] = (f32x4){0.f, 0.f, 0.f, 0.f}; if (ncoln >= 0) nval[it] = *(const f32x4*)(wn.src + (size_t)(wn.k0 + kk + it * 32) * wn.lds_src + ncoln); } }
#pragma unroll
    for (int it = 0; it < 4; ++it) {
      const int k = kk + it * 32;
      tile[k * 65 + c4 + 0] = val[it][0]; tile[k * 65 + c4 + 1] = val[it][1]; tile[k * 65 + c4 + 2] = val[it][2]; tile[k * 65 + c4 + 3] = val[it][3];
    }
    __syncthreads();
    { const int nn = tid >> 3, k16 = (tid & 7) * 16;
#pragma unroll
      for (int h2 = 0; h2 < 2; ++h2) { const int k8 = k16 + h2 * 8; uint4 ww;
        ww.x = pk2(tile[(k8 + 0) * 65 + nn], tile[(k8 + 1) * 65 + nn]); ww.y = pk2(tile[(k8 + 2) * 65 + nn], tile[(k8 + 3) * 65 + nn]);
        ww.z = pk2(tile[(k8 + 4) * 65 + nn], tile[(k8 + 5) * 65 + nn]); ww.w = pk2(tile[(k8 + 6) * 65 + nn], tile[(k8 + 7) * 65 + nn]);
        *(uint4*)(w.dst + (size_t)(w.np0 + nn) * w.K + w.k0 + k8) = ww; } }
    __syncthreads();
#pragma unroll
    for (int it = 0; it < 4; ++it) val[it] = nval[it];
  }
}

DI void cnt8(unsigned k0, unsigned k1, unsigned k2, unsigned k3, unsigned k4, unsigned k5, unsigned k6, unsigned k7, unsigned cand, int& lacc) {
  unsigned long long m0, m1, m2, m3, m4, m5, m6, m7, t0;
  asm("v_cmp_ge_u32_e64 %0, %10, %18\n\tv_cmp_ge_u32_e64 %1, %11, %18\n\tv_cmp_ge_u32_e64 %2, %12, %18\n\tv_cmp_ge_u32_e64 %3, %13, %18\n\t"
      "v_cmp_ge_u32_e64 %4, %14, %18\n\tv_cmp_ge_u32_e64 %5, %15, %18\n\tv_cmp_ge_u32_e64 %6, %16, %18\n\tv_cmp_ge_u32_e64 %7, %17, %18\n\t"
      "v_addc_co_u32_e64 %9, %8, 0, %9, %0\n\tv_addc_co_u32_e64 %9, %8, 0, %9, %1\n\tv_addc_co_u32_e64 %9, %8, 0, %9, %2\n\tv_addc_co_u32_e64 %9, %8, 0, %9, %3\n\t"
      "v_addc_co_u32_e64 %9, %8, 0, %9, %4\n\tv_addc_co_u32_e64 %9, %8, 0, %9, %5\n\tv_addc_co_u32_e64 %9, %8, 0, %9, %6\n\tv_addc_co_u32_e64 %9, %8, 0, %9, %7"
      : "=&s"(m0), "=&s"(m1), "=&s"(m2), "=&s"(m3), "=&s"(m4), "=&s"(m5), "=&s"(m6), "=&s"(m7), "=&s"(t0), "+v"(lacc)
      : "v"(k0), "v"(k1), "v"(k2), "v"(k3), "v"(k4), "v"(k5), "v"(k6), "v"(k7), "s"(cand));
}
DI int wave_total(int v) {
  v += __builtin_amdgcn_mov_dpp(v, 0xB1, 0xF, 0xF, true);
  v += __builtin_amdgcn_mov_dpp(v, 0x4E, 0xF, 0xF, true);
  v += __builtin_amdgcn_mov_dpp(v, 0x124, 0xF, 0xF, true);
  v += __builtin_amdgcn_mov_dpp(v, 0x128, 0xF, 0xF, true);
  return (__builtin_amdgcn_readlane(v, 0) + __builtin_amdgcn_readlane(v, 16)) + (__builtin_amdgcn_readlane(v, 32) + __builtin_amdgcn_readlane(v, 48));
}
DI int count_ge(const unsigned (&key)[64], unsigned cand, int nj) {
  int lacc = 0;
  const int ng = __builtin_amdgcn_readfirstlane((nj + 7) >> 3);
#pragma unroll
  for (int g = 0; g < 8; ++g) {
    if (g < ng) cnt8(key[g * 8], key[g * 8 + 1], key[g * 8 + 2], key[g * 8 + 3], key[g * 8 + 4], key[g * 8 + 5], key[g * 8 + 6], key[g * 8 + 7], cand, lacc);
  }
  return wave_total(lacc);
}
DI void phase_score_select(const Params& p) {
  const int tid = opaque_tid(), lane = tid & 63, wave = __builtin_amdgcn_readfirstlane(tid >> 6);
  float* sc = p.sscr + (size_t)blockIdx.x * (16 * 4096);
  for (int unit = blockIdx.x; unit < NTOK / 16; unit += gridDim.x) {
    const int b = unit & 3, kq = unit / (int)gridDim.x, jq = (unit % (int)gridDim.x) >> 2;
    const int strip = (gridDim.x == 256) ? (kq == 0 ? 255 - jq : (kq == 1 ? 128 + jq : (kq == 2 ? 127 - jq : jq))) : 255 - (unit >> 2);
    const int t0 = strip * 16;
    const size_t tokb = (size_t)b * SEQ;
    {
      bf16x8 aq[4][2];
#pragma unroll
      for (int hd = 0; hd < 4; ++hd)
#pragma unroll
        for (int c = 0; c < 2; ++c) aq[hd][c] = *(const bf16x8*)(p.iq + (tokb + t0 + (lane & 15)) * 256 + hd * 64 + c * 32 + (lane >> 4) * 8);
      f32x4 wts[4];
#pragma unroll
      for (int i = 0; i < 4; ++i) wts[i] = *(const f32x4*)(p.iw + (tokb + t0 + (lane >> 4) * 4 + i) * 4);
      for (int rep_ = 0; rep_ < SCORE_REP; ++rep_)
      for (int kt = wave; kt <= (strip | 3); kt += 8) {
        bf16x8 bk[2];
#pragma unroll
        for (int c = 0; c < 2; ++c) bk[c] = *(const bf16x8*)(p.ik + (tokb + kt * 16 + (lane & 15)) * 64 + c * 32 + (lane >> 4) * 8);
        f32x4 s = {0.f, 0.f, 0.f, 0.f};
#pragma unroll
        for (int hd = 0; hd < 4; ++hd) {
          f32x4 a = {0.f, 0.f, 0.f, 0.f};
          a = __builtin_amdgcn_mfma_f32_16x16x32_bf16(aq[hd][0], bk[0], a, 0, 0, 0);
          a = __builtin_amdgcn_mfma_f32_16x16x32_bf16(aq[hd][1], bk[1], a, 0, 0, 0);
#pragma unroll
          for (int i = 0; i < 4; ++i) s[i] += wts[i][hd] * fmaxf(a[i], 0.f);
        }
        const int key = kt * 16 + (lane & 15);
#pragma unroll
        for (int i = 0; i < 4; ++i) { int q = (lane >> 4) * 4 + i; sc[q * 4096 + key] = (key <= t0 + q) ? (s[i] + 0.0f) : -INFINITY; }
      }
    }
    __threadfence_block();
    __syncthreads();
    for (int rep_ = 0; rep_ < SEL_REP; ++rep_)
    for (int q = wave; q < 16; q += 8) {
      const int t = t0 + q; const int nj = (t >> 6) + 1;
      unsigned key[64];
      {
        const float* rowp = sc + q * 4096;
        int vv[64];
#pragma unroll
        for (int j = 0; j < 64; ++j) vv[j] = (j < nj) ? __float_as_int(rowp[j * 64 + lane]) : (int)0xff800000u;
        __builtin_amdgcn_sched_barrier(0);
#pragma unroll
        for (int j = 0; j < 64; ++j) key[j] = (unsigned)vv[j] ^ ((unsigned)(vv[j] >> 31) | 0x80000000u);
      }
      unsigned T = 0x00800000u; bool fast = true; int need = 0;
      if (t + 1 > 256) {
        T = 0; bool found = false;
        for (int bit = 31; bit >= 0; --bit) {
          unsigned cand = T | (1u << bit); int c = count_ge(key, cand, nj);
          if (c >= 256) { T = cand; if (c == 256) { found = true; break; } }
        }
        if (!found) { fast = false; int cgt = (T == 0xFFFFFFFFu) ? 0 : count_ge(key, T + 1, nj); need = 256 - cgt; }
      }
      unsigned long long myword = 0ull;
      if (fast) {
#pragma unroll
        for (int j = 0; j < 64; ++j) { unsigned long long sm = __ballot(key[j] >= T); if (lane == j) myword = sm; }
      } else {
        int run = 0;
#pragma unroll
        for (int j = 0; j < 64; ++j) {
          unsigned long long eqm = __ballot(key[j] == T);
          int pre = __builtin_amdgcn_mbcnt_hi((unsigned)(eqm >> 32), __builtin_amdgcn_mbcnt_lo((unsigned)eqm, 0u));
          bool sel = (key[j] > T) || (key[j] == T && (run + pre) < need);
          unsigned long long sm = __ballot(sel);
          run += __popcll(eqm);
          if (lane == j) myword = sm;
          __builtin_amdgcn_sched_barrier(0);
        }
      }
      ((unsigned long long*)p.bitmask)[(tokb + t) * 64 + lane] = myword;
    }
    __syncthreads();
  }
}

DI int crow(int r, int hi) { return (r & 3) + 8 * (r >> 2) + 4 * hi; }
#define MFMA32(a, b, c) __builtin_amdgcn_mfma_f32_32x32x16_bf16(a, b, c, 0, 0, 0)
DI bf16x8 pack_step(const f32x16& x, int s) {
  uint4 w; w.x = pk2(x[8 * s], x[8 * s + 1]); w.y = pk2(x[8 * s + 2], x[8 * s + 3]); w.z = pk2(x[8 * s + 4], x[8 * s + 5]); w.w = pk2(x[8 * s + 6], x[8 * s + 7]);
  return __builtin_bit_cast(bf16x8, w);
}
DI float swap_max(float m) { auto rr = __builtin_amdgcn_permlane32_swap(__float_as_uint(m), __float_as_uint(m), false, false); return fmaxf(__uint_as_float(rr[0]), __uint_as_float(rr[1])); }

template <int MODE>
DI void attn_wave(const Params& p, int l, int b, int h, int qblk, bool do_store) {
  const int lane = opaque_tid() & 63, r32 = lane & 31, hi = lane >> 5;
  const int q0 = qblk * 32, t = q0 + r32;
  const size_t tok = (size_t)b * SEQ + t;
  bf16_t* Q; const bf16_t *Kb, *Vb, *Gt; int bh;
  if (MODE == 0) { Q = p.zAq; bh = b * 8 + h; Kb = p.zAk; Vb = p.zAv; Gt = p.zAg; }
  else if (MODE == 1) { Q = p.zBq; bh = b * 2 + (h >> 2); Kb = p.zBk; Vb = p.zBv; Gt = p.zBg; }
  else { Q = p.zCq; bh = b * 8 + h; Kb = p.zCk; Vb = p.zCv; Gt = p.zCg; }
  Kb += (size_t)bh * NT32 * 2048; Vb += (size_t)bh * NT32 * 2048;
  bf16_t* qp = Q + tok * 512 + h * 64;
  bf16x8 qr[4];
#pragma unroll
  for (int d0 = 0; d0 < 4; ++d0) qr[d0] = *(const bf16x8*)(qp + d0 * 16 + hi * 8);
  f32x16 o0 = {}, o1 = {};
  float m = -1e30f, lsum = 0.f, carry = 1.0f;
  int kt_lo = 0, kt_hi = (q0 + 31) >> 6;
  if (MODE == 1) { int lo = q0 - 127; kt_lo = lo > 0 ? (lo >> 6) : 0; m = p.sinks[l * 8 + h] * LOG2E; lsum = hi == 0 ? 1.0f : 0.0f; }
  if (MODE == 2) { kt_hi = q0 > 0 ? ((q0 + 30) >> 6) : 0; }
  const unsigned* bmrow = p.bitmask + tok * 128;
  bf16x8 kf[2][4], vf[2][4];
  { const int kt = (MODE == 2) ? kt_hi : kt_lo;
    const bf16_t* kp = Kb + (size_t)kt * 4096 + lane * 8; const bf16_t* vp = Vb + (size_t)kt * 4096 + lane * 8;
#pragma unroll
    for (int kh = 0; kh < 2; ++kh)
#pragma unroll
      for (int d0 = 0; d0 < 4; ++d0) { kf[kh][d0] = *(const bf16x8*)(kp + kh * 2048 + d0 * 512); vf[kh][d0] = *(const bf16x8*)(vp + kh * 2048 + d0 * 512); } }
  for (int it = 0; it <= kt_hi - kt_lo; ++it) {
    const int kt = (MODE == 2) ? (kt_hi - it) : (kt_lo + it);
    const bool has_nx = it < kt_hi - kt_lo;
    const int ktn = has_nx ? ((MODE == 2) ? kt - 1 : kt + 1) : kt;
    f32x16 p0 = {}, p1 = {};
#pragma unroll
    for (int d0 = 0; d0 < 4; ++d0) { p0 = MFMA32(kf[0][d0], qr[d0], p0); p1 = MFMA32(kf[1][d0], qr[d0], p1); }
    if (has_nx) { const bf16_t* kp = Kb + (size_t)ktn * 4096 + lane * 8;
#pragma unroll
      for (int kh = 0; kh < 2; ++kh)
#pragma unroll
        for (int d0 = 0; d0 < 4; ++d0) kf[kh][d0] = *(const bf16x8*)(kp + kh * 2048 + d0 * 512); }
    const int kbase = kt * 64 + 4 * hi;
    if (MODE == 0 || MODE == 1) {
      unsigned w0 = 0xffffffffu, w1 = 0xffffffffu;
      if (MODE == 0) { uint2 ww = *(const uint2*)(bmrow + kt * 2); w0 = ww.x >> (4 * hi); w1 = ww.y >> (4 * hi); }
      float mx = -INFINITY;
#pragma unroll
      for (int r = 0; r < 16; ++r) {
        const int bit = (r & 3) + 8 * (r >> 2);
        bool v0, v1;
        if (MODE == 0) { v0 = (w0 >> bit) & 1u; v1 = (w1 >> bit) & 1u; }
        else { int k0 = kbase + bit, k1 = k0 + 32; v0 = (k0 <= t) && (k0 > t - 128); v1 = (k1 <= t) && (k1 > t - 128); }
        p0[r] = v0 ? p0[r] * C2 : -INFINITY; p1[r] = v1 ? p1[r] * C2 : -INFINITY;
        mx = fmaxf(mx, fmaxf(p0[r], p1[r]));
      }
      mx = swap_max(mx);
      const float mn = fmaxf(m, mx), alpha = __builtin_amdgcn_exp2f(m - mn);
      m = mn; float ps = 0.f;
#pragma unroll
      for (int r = 0; r < 16; ++r) { p0[r] = __builtin_amdgcn_exp2f(p0[r] - mn); p1[r] = __builtin_amdgcn_exp2f(p1[r] - mn); ps += p0[r] + p1[r]; }
      lsum = lsum * alpha + ps;
#pragma unroll
      for (int r = 0; r < 16; ++r) { o0[r] *= alpha; o1[r] *= alpha; }
    } else {
      float Gs[16];
#pragma unroll
      for (int kh = 0; kh < 2; ++kh) {
#pragma unroll
        for (int rq = 0; rq < 4; ++rq) {
          float be[4], rr[4];
#pragma unroll
          for (int i = 0; i < 4; ++i) {
            const int r = rq * 4 + i; const int key = kbase + kh * 32 + (r & 3) + 8 * (r >> 2);
            float sv = kh == 0 ? p0[r] : p1[r];
            float e = __builtin_amdgcn_exp2f(fminf(sv * C2, 80.f));
            float rc = __builtin_amdgcn_rcpf(1.0f + e);
            bool valid = key < t;
            be[i] = valid ? e * rc : 0.f; rr[i] = valid ? rc : 1.0f;
          }
          float s2 = rr[3], s1 = s2 * rr[2], s0 = s1 * rr[1], G = s0 * rr[0];
          float a0 = be[0] * s0, a1 = be[1] * s1, a2 = be[2] * s2, a3 = be[3];
          if (kh == 0) { p0[rq * 4] = a0; p0[rq * 4 + 1] = a1; p0[rq * 4 + 2] = a2; p0[rq * 4 + 3] = a3; }
          else { p1[rq * 4] = a0; p1[rq * 4 + 1] = a1; p1[rq * 4 + 2] = a2; p1[rq * 4 + 3] = a3; }
          auto sw = __builtin_amdgcn_permlane32_swap(__float_as_uint(G), __float_as_uint(G), false, false);
          Gs[kh * 8 + rq * 2] = __uint_as_float(sw[0]); Gs[kh * 8 + rq * 2 + 1] = __uint_as_float(sw[1]);
        }
      }
      float E[16]; E[15] = carry;
#pragma unroll
      for (int g = 14; g >= 0; --g) E[g] = E[g + 1] * Gs[g + 1];
      carry = E[0] * Gs[0];
#pragma unroll
      for (int kh = 0; kh < 2; ++kh)
#pragma unroll
        for (int rq = 0; rq < 4; ++rq) {
          float ev = hi ? E[kh * 8 + rq * 2 + 1] : E[kh * 8 + rq * 2];
#pragma unroll
          for (int i = 0; i < 4; ++i) { if (kh == 0) p0[rq * 4 + i] *= ev; else p1[rq * 4 + i] *= ev; }
        }
    }
#pragma unroll
    for (int s = 0; s < 2; ++s) {
      bf16x8 pa = pack_step(p0, s), pb = pack_step(p1, s);
      o0 = MFMA32(vf[0][0 * 2 + s], pa, o0); o1 = MFMA32(vf[0][1 * 2 + s], pa, o1);
      o0 = MFMA32(vf[1][0 * 2 + s], pb, o0); o1 = MFMA32(vf[1][1 * 2 + s], pb, o1);
    }
    if (MODE == 2) { if (__ballot(carry > 1e-20f) == 0ull) break; }
    if (has_nx) { const bf16_t* vp = Vb + (size_t)ktn * 4096 + lane * 8;
#pragma unroll
      for (int kh = 0; kh < 2; ++kh)
#pragma unroll
        for (int d0 = 0; d0 < 4; ++d0) vf[kh][d0] = *(const bf16x8*)(vp + kh * 2048 + d0 * 512); }
  }
  float inv = 1.0f;
  if (MODE != 2) { auto rr = __builtin_amdgcn_permlane32_swap(__float_as_uint(lsum), __float_as_uint(lsum), false, false); inv = 1.0f / (__uint_as_float(rr[0]) + __uint_as_float(rr[1])); }
  const bf16_t* gp = Gt + tok * 512 + h * 64;
#pragma unroll
  for (int dt = 0; dt < 2; ++dt)
#pragma unroll
    for (int rq = 0; rq < 4; ++rq) {
      const int d = dt * 32 + 8 * rq + 4 * hi;
      uint2 gw = *(const uint2*)(gp + d);
      f32x4 v;
#pragma unroll
      for (int i = 0; i < 4; ++i) v[i] = (dt == 0 ? o0[rq * 4 + i] : o1[rq * 4 + i]) * inv;
      v[0] *= __uint_as_float(gw.x << 16); v[1] *= __uint_as_float(gw.x & 0xffff0000u); v[2] *= __uint_as_float(gw.y << 16); v[3] *= __uint_as_float(gw.y & 0xffff0000u);
      if (do_store) st4bf(qp + d, v);
    }
}
DI void attn_A_wg(const Params& p, int b, int h, int g, LAS unsigned char* lds, bool do_store) {
  const int tid = opaque_tid(), lane = tid & 63, wave = __builtin_amdgcn_readfirstlane(tid >> 6), r32 = lane & 31, hi = lane >> 5;
  const int qblk = g * 8 + wave, q0 = qblk * 32, t = q0 + r32;
  const size_t tok = (size_t)b * SEQ + t;
  const int bh = b * 8 + h;
  bf16_t* qp = p.zAq + tok * 512 + h * 64;
  bf16x8 qr[4];
#pragma unroll
  for (int d0 = 0; d0 < 4; ++d0) qr[d0] = *(const bf16x8*)(qp + d0 * 16 + hi * 8);
  const u32x4* kg = (const u32x4*)(p.zAk + (size_t)bh * NT32 * 2048) + tid;
  const u32x4* vg = (const u32x4*)(p.zAv + (size_t)bh * NT32 * 2048) + tid;
  const int kt_end = 4 * g + 3, my_hi = (q0 + 31) >> 6;
  const unsigned* bmrow = p.bitmask + tok * 128;
  const bf16_t* gp = p.zAg + tok * 512 + h * 64;
  uint2 gwv[2][4];
#pragma unroll
  for (int dt = 0; dt < 2; ++dt)
#pragma unroll
    for (int rq = 0; rq < 4; ++rq) gwv[dt][rq] = *(const uint2*)(gp + dt * 32 + 8 * rq + 4 * hi);
  f32x16 o0 = {}, o1 = {};
  float m = -1e30f, lsum = 0.f;
  __syncthreads();
  { u32x4 rk = kg[0], rv = vg[0];
    *(LAS u32x4*)(lds + tid * 16) = rk; *(LAS u32x4*)(lds + 8192 + tid * 16) = rv; }
  __syncthreads();
  uint2 ww_nxt = *(const uint2*)bmrow;
  for (int kt = 0; kt <= kt_end; ++kt) {
    u32x4 rk, rv;
    if (kt < kt_end) { rk = kg[(size_t)(kt + 1) * 512]; rv = vg[(size_t)(kt + 1) * 512]; }
    const uint2 ww = ww_nxt;
    if (kt + 1 <= my_hi) ww_nxt = *(const uint2*)(bmrow + (kt + 1) * 2);
    if (kt <= my_hi) {
      LAS unsigned char* kb = lds + (kt & 1) * 16384 + lane * 16;
      LAS unsigned char* vb = kb + 8192;
      bf16x8 kf[8], vf[8];
#pragma unroll
      for (int i = 0; i < 8; ++i) kf[i] = *(const LAS bf16x8*)(kb + i * 1024);
#pragma unroll
      for (int i = 0; i < 8; ++i) vf[i] = *(const LAS bf16x8*)(vb + i * 1024);
      f32x16 p0 = {}, p1 = {};
#pragma unroll
      for (int d0 = 0; d0 < 4; ++d0) { p0 = MFMA32(kf[d0], qr[d0], p0); p1 = MFMA32(kf[4 + d0], qr[d0], p1); }
      float mx = fmaxf(p0[0], p1[0]);
#pragma unroll
      for (int r = 1; r < 16; ++r) mx = fmaxf(mx, fmaxf(p0[r], p1[r]));
      mx = swap_max(mx) * C2;
      const float mn = fmaxf(m, mx);
      if (__builtin_amdgcn_ballot_w64(mn - m > 8.0f) != 0ull) {
        const float alpha = __builtin_amdgcn_exp2f(m - mn);
        lsum *= alpha;
#pragma unroll
        for (int r = 0; r < 16; ++r) { o0[r] *= alpha; o1[r] *= alpha; }
        m = mn;
      }
      const int w0 = (int)(ww.x >> (4 * hi)), w1 = (int)(ww.y >> (4 * hi));
      const f32x2 nm2 = {-m, -m}, c22 = {C2, C2};
      f32x2 ps2 = {0.f, 0.f};
#pragma unroll
      for (int r = 0; r < 16; r += 2) {
        const int bit0 = (r & 3) + 8 * (r >> 2), bit1 = bit0 + 1;
        const f32x2 a0 = (f32x2){p0[r], p0[r + 1]} * c22 + nm2, a1 = (f32x2){p1[r], p1[r + 1]} * c22 + nm2;
        f32x2 e0, e1;
        e0.x = __uint_as_float(__float_as_uint(__builtin_amdgcn_exp2f(a0.x)) & (unsigned)__builtin_amdgcn_sbfe(w0, bit0, 1));
        e0.y = __uint_as_float(__float_as_uint(__builtin_amdgcn_exp2f(a0.y)) & (unsigned)__builtin_amdgcn_sbfe(w0, bit1, 1));
        e1.x = __uint_as_float(__float_as_uint(__builtin_amdgcn_exp2f(a1.x)) & (unsigned)__builtin_amdgcn_sbfe(w1, bit0, 1));
        e1.y = __uint_as_float(__float_as_uint(__builtin_amdgcn_exp2f(a1.y)) & (unsigned)__builtin_amdgcn_sbfe(w1, bit1, 1));
        p0[r] = e0.x; p0[r + 1] = e0.y; p1[r] = e1.x; p1[r + 1] = e1.y;
        ps2 += e0 + e1;
      }
      const float ps = ps2.x + ps2.y;
      lsum += ps;
#pragma unroll
      for (int s2 = 0; s2 < 2; ++s2) {
        bf16x8 pa = pack_step(p0, s2), pb = pack_step(p1, s2);
        o0 = MFMA32(vf[0 * 2 + s2], pa, o0); o1 = MFMA32(vf[1 * 2 + s2], pa, o1);
        o0 = MFMA32(vf[4 + 0 * 2 + s2], pb, o0); o1 = MFMA32(vf[4 + 1 * 2 + s2], pb, o1);
      }
    }
    if (kt < kt_end) { LAS unsigned char* nb = lds + ((kt + 1) & 1) * 16384 + tid * 16; *(LAS u32x4*)nb = rk; *(LAS u32x4*)(nb + 8192) = rv; }
    __syncthreads();
  }
  auto rr = __builtin_amdgcn_permlane32_swap(__float_as_uint(lsum), __float_as_uint(lsum), false, false);
  const float inv = 1.0f / (__uint_as_float(rr[0]) + __uint_as_float(rr[1]));
#pragma unroll
  for (int dt = 0; dt < 2; ++dt)
#pragma unroll
    for (int rq = 0; rq < 4; ++rq) {
      const int d = dt * 32 + 8 * rq + 4 * hi;
      const uint2 gw = gwv[dt][rq];
      f32x4 v;
#pragma unroll
      for (int i = 0; i < 4; ++i) v[i] = (dt == 0 ? o0[rq * 4 + i] : o1[rq * 4 + i]) * inv;
      v[0] *= __uint_as_float(gw.x << 16); v[1] *= __uint_as_float(gw.x & 0xffff0000u); v[2] *= __uint_as_float(gw.y << 16); v[3] *= __uint_as_float(gw.y & 0xffff0000u);
      if (do_store) st4bf(qp + d, v);
    }
}
DI void phase_attn(const Params& p, int l, LAS unsigned char* lds, int which) {
  const int wave = __builtin_amdgcn_readfirstlane(opaque_tid() >> 6);
  for (int u = (which == 0 ? 0 : 512) + blockIdx.x; u < (which == 0 ? 512 : 512 * 3); u += gridDim.x) {
    const int mode = u / 512, v = u % 512, rnd = v >> 8, c = v & 255;
    const int bhh = c & 31, g = rnd == 0 ? 15 - (c >> 5) : (c >> 5);
    const int b = bhh >> 3, h = bhh & 7, qblk = g * 8 + wave;
    if (mode == 0) { for (int r = 0; r < ATT_REP_A; ++r) attn_A_wg(p, b, h, g, lds, r == ATT_REP_A - 1); }
    else if (mode == 1) { for (int r = 0; r < ATT_REP_B; ++r) attn_wave<1>(p, l, b, h, qblk, r == ATT_REP_B - 1); }
    else { for (int r = 0; r < ATT_REP_C; ++r) attn_wave<2>(p, l, b, h, qblk, r == ATT_REP_C - 1); }
  }
}

DI void phase_final(const Params& p) {
  const int tid_ = opaque_tid(), lane = tid_ & 63, wave = __builtin_amdgcn_readfirstlane(tid_ >> 6);
  for (int row0 = (blockIdx.x * 8 + wave) * 4; row0 < NTOK; row0 += gridDim.x * 32) {
    f32x4 v[4][4]; float ss[4] = {0.f, 0.f, 0.f, 0.f};
#pragma unroll
    for (int r = 0; r < 4; ++r)
#pragma unroll
      for (int i = 0; i < 4; ++i) v[r][i] = *(const f32x4*)(p.out + (size_t)(row0 + r) * 1024 + i * 256 + lane * 4);
    f32x4 gg[4];
#pragma unroll
    for (int i = 0; i < 4; ++i) gg[i] = *(const f32x4*)(p.final_g + i * 256 + lane * 4);
#pragma unroll
    for (int r = 0; r < 4; ++r) {
#pragma unroll
      for (int i = 0; i < 4; ++i) ss[r] += v[r][i][0] * v[r][i][0] + v[r][i][1] * v[r][i][1] + v[r][i][2] * v[r][i][2] + v[r][i][3] * v[r][i][3];
      ss[r] = wave_sum(ss[r]);
    }
#pragma unroll
    for (int i = 0; i < 4; ++i) {
      int col = i * 256 + lane * 4; const f32x4 g = gg[i];
#pragma unroll
      for (int r = 0; r < 4; ++r) { const float rstd = rsqrtf(ss[r] * (1.0f / 1024.0f) + 1e-6f); *(f32x4*)(p.out + (size_t)(row0 + r) * 1024 + col) = v[r][i] * rstd * g; }
    }
  }
}

#define XB_TMO      128
#define XB_XCNT(j)  (256  + 64 * (j))
#define XB_XSUB(j)  (1280 + 64 * (j))
#define XB_XGEN(j)  (2304 + 64 * (j))
#define XB_TOP      3328
#define XB_TOPGEN   3392
#define XCD_BAR_WORDS 3456
#define XB_SPIN_CAP (1u << 18)
DI unsigned xb_ld(unsigned* p) { return __hip_atomic_load(p, __ATOMIC_RELAXED, __HIP_MEMORY_SCOPE_AGENT); }
DI unsigned xb_add(unsigned* p, unsigned v) { return __hip_atomic_fetch_add(p, v, __ATOMIC_RELAXED, __HIP_MEMORY_SCOPE_AGENT); }
DI unsigned xb_xcc_id() { return (unsigned)__builtin_amdgcn_s_getreg((3 << 11) | 20) & 0xFu; }
#define XB_SPIN(cond, bar) do { unsigned _sp = 0; while (cond) { __builtin_amdgcn_s_sleep(1); \
    if ((++_sp & 255u) == 0u) { if (xb_ld(&(bar)[XB_TMO])) break; if (_sp > XB_SPIN_CAP) { atomicAdd(&(bar)[XB_TMO], 1u); break; } } } } while (0)
struct XcdBarrier { unsigned* bar; unsigned x; volatile LAS unsigned* st; };
DI XcdBarrier xcd_barrier_post(unsigned* bar, volatile LAS unsigned* st) {
  XcdBarrier b; b.bar = bar; b.x = xb_xcc_id(); b.st = st;
  if (threadIdx.x == 0) (void)xb_add(&bar[XB_XCNT(b.x)], 1u);
  return b;
}
DI void xcd_barrier_complete(unsigned* bar, unsigned x, unsigned& nloc, unsigned& nx) {
  const unsigned G = gridDim.x * gridDim.y * gridDim.z;
  unsigned sum, cnt, mine, sp = 0u;
  for (;;) {
    sum = 0u; cnt = 0u; mine = 0u;
#pragma unroll
    for (unsigned j = 0; j < 16; ++j) { const unsigned c = xb_ld(&bar[XB_XCNT(j)]); sum += c; cnt += (c > 0u) ? 1u : 0u; mine = (j == x) ? c : mine; }
    if (sum == G) break;
    __builtin_amdgcn_s_sleep(1);
    if ((++sp & 255u) == 0u) { if (xb_ld(&bar[XB_TMO])) break; if (sp > XB_SPIN_CAP) { atomicAdd(&bar[XB_TMO], 1u); break; } }
  }
  nloc = mine > 0u ? mine : 1u; nx = cnt > 0u ? cnt : 1u;
}
DI void xcd_barrier(const XcdBarrier& b) {
  asm volatile("s_waitcnt vmcnt(0)" ::: "memory");
  __syncthreads();
  if (threadIdx.x == 0) {
    unsigned* bar = b.bar;
    __builtin_amdgcn_s_waitcnt(0);
    unsigned nloc = b.st[0], nx = b.st[1];
    if (nloc == 0u) { xcd_barrier_complete(bar, b.x, nloc, nx); b.st[0] = nloc; b.st[1] = nx; }
    const unsigned old = xb_add(&bar[XB_XSUB(b.x)], 1u);
    const unsigned gen = old / nloc;
    if (old + 1u == (gen + 1u) * nloc) {
      __builtin_amdgcn_fence(__ATOMIC_RELEASE, "agent");
      asm volatile("s_waitcnt vmcnt(0)" ::: "memory");
      const unsigned og = xb_add(&bar[XB_TOP], 1u);
      const unsigned tg = og / nx;
      if (og + 1u == (tg + 1u) * nx) xb_add(&bar[XB_TOPGEN], 1u);
      else XB_SPIN(xb_ld(&bar[XB_TOPGEN]) == tg, bar);
      __builtin_amdgcn_fence(__ATOMIC_ACQUIRE, "agent");
      xb_add(&bar[XB_XGEN(b.x)], 1u);
      asm volatile("s_waitcnt vmcnt(0)" ::: "memory");
    } else {
      XB_SPIN(xb_ld(&bar[XB_XGEN(b.x)]) == gen, bar);
      __builtin_amdgcn_fence(__ATOMIC_ACQUIRE, "agent");
      asm volatile("s_waitcnt vmcnt(0)" ::: "memory");
    }
  }
  __syncthreads();
}

struct KArgs { const float* in[12]; float* out; char* ws; };
constexpr size_t MiB = 1 << 20;
constexpr size_t OFF_ROPE = 0, OFF_MOD = OFF_ROPE + 1 * MiB, OFF_U = OFF_MOD + 98304, OFF_WTIN = OFF_U + 32 * MiB, OFF_WTBR = OFF_WTIN + (size_t)WT_IN_ROWS * 2048,
  OFF_WTOUT = OFF_WTBR + 3 * MiB, OFF_ZA = OFF_WTOUT + 2 * MiB, OFF_ZB = OFF_ZA + 64 * MiB, OFF_ZC = OFF_ZB + 40 * MiB, OFF_IQ = OFF_ZC + 64 * MiB, OFF_IK = OFF_IQ + 8 * MiB,
  OFF_IW = OFF_IK + 2 * MiB, OFF_BM = OFF_IW + (size_t)NTOK * 16, OFF_BAR = OFF_BM + 8 * MiB, OFF_END = OFF_BAR + 16384;
#define TPM(t) ((((t) & 7) << 3) + ((t) >> 5))
#define TPN(t) (((t) >> 3) & 3)
DI GemmTile main_tile(const char* wsb, int t) {
  const bool is_idx = t < 128; const int tt = is_idx ? t : t - 128;
  const int pn = is_idx ? (tt & 1) : (tt / 64), pm = is_idx ? (tt >> 1) : (tt % 64);
  GemmTile g; g.A = (const bf16_t*)(wsb + OFF_U); g.Bt = (const bf16_t*)(wsb + OFF_WTIN + (is_idx ? (size_t)COL_IDX * 2048 : (size_t)0)); g.K = 1024; g.brow = pm * 256; g.bcol = pn * 256; return g;
}
DI GemmTile merged_tile(const char* wsb, int t, int st) {
  const int pm = TPM(t), pn = TPN(t), x = st >> 1, kind = st & 1;
  const size_t aoff = kind == 0 ? OFF_U : (x == 0 ? OFF_ZA : (x == 1 ? OFF_ZB : OFF_ZB + 16 * MiB));
  const size_t boff = kind == 0 ? OFF_WTIN + (size_t)(COL_GATE + x * 1024) * 2048 : OFF_WTBR + (size_t)x * 1024 * 1024;
  GemmTile g; g.A = (const bf16_t*)(wsb + aoff); g.Bt = (const bf16_t*)(wsb + boff);
  g.K = kind == 0 ? 1024 : 512; g.brow = pm * 256; g.bcol = pn * 256; return g;
}
DI GemmTile out_tile(const char* wsb, int t) { GemmTile g; g.A = (const bf16_t*)(wsb + OFF_ZA + 16 * MiB); g.Bt = (const bf16_t*)(wsb + OFF_WTOUT); g.K = 1024; g.brow = TPM(t) * 256; g.bcol = TPN(t) * 256; return g; }
DI void run_phase(const Params& p, int ph, char* lds) {
  LAS unsigned char* shm = (LAS unsigned char*)lds;
  if (ph == 0) { phase_prep(p, lds); return; }
  if (ph == 15) { phase_final(p); return; }
  const int l = (ph - 1) / 7, sub = (ph - 1) % 7;
  const float* xin = l == 0 ? p.x : p.out;
  const char* wsb = (const char*)p.rope;
  if (sub == 0) { phase_a(p, l, xin, lds); }
  else if (sub == 1) {
    const int NTL = 128 + 64 * 21;
    if ((int)blockIdx.x < NTL) gemm_prologue(main_tile(wsb, blockIdx.x), shm);
    for (int t = blockIdx.x; t < NTL; t += gridDim.x) {
      const bool is_idx = t < 128;
      const int tt = is_idx ? t : t - 128;
      const int pn = is_idx ? (tt & 1) : (tt / 64), pm = is_idx ? (tt >> 1) : (tt % 64);
      const int tn = t + gridDim.x; const bool hn = tn < NTL;
      gemm256<true>(main_tile(wsb, t), hn, main_tile(wsb, hn ? tn : t), shm, [=](int ai, int bj, int m, f32x4 v0, f32x4 v1, int tid, int wr, int wc, int fr, int fq) {
        const int row = pm * 256 + ai * 128 + wr * 64 + m * 16 + fr; const int G = (pn * 256 + bj * 128 + wc * 32) >> 6;
        if (is_idx) epi_idx(p, row, G, (wc & 1) * 16 + fq * 4, v0, v1); else epi_main(p, row, G, (wc & 1) * 16 + fq * 4, v0, v1); });
    }
  }
  else if (sub == 2) { phase_attn(p, l, shm, 1); }
  else if (sub == 3) { phase_score_select(p); }
  else if (sub == 4) { phase_attn(p, l, shm, 0); }
  else if (sub == 5) {
    uint2* scr = (uint2*)(p.sigscr + (size_t)blockIdx.x * 65536);
    if ((int)blockIdx.x < 256) gemm_prologue(merged_tile(wsb, blockIdx.x, 0), shm);
    for (int t = blockIdx.x; t < 256; t += gridDim.x) {
      const int pm = TPM(t), pn = TPN(t);
#pragma unroll 1
      for (int st = 0; st < 6; ++st) {
        const int x = st >> 1, kind = st & 1;
        const bool lastst = st == 5; const int tn = lastst ? t + (int)gridDim.x : t; const bool hn = tn < 256;
        gemm256<false>(merged_tile(wsb, t, st), hn, merged_tile(wsb, hn ? tn : t, lastst ? 0 : st + 1), shm, [=](int ai, int bj, const f32x4 (&a)[4][2], int tid, int wr, int wc, int fr, int fq) {
          const int idx0 = (ai * 2 + bj) * 4;
          const int row0 = pm * 256 + ai * 128 + wr * 64 + fr; const int col = pn * 256 + bj * 128 + wc * 32 + fq * 4;
          if (kind == 0) {
#pragma unroll
            for (int m = 0; m < 4; ++m) {
              f32x4 s0, s1;
              for (int j = 0; j < 4; ++j) { s0[j] = fsigmoid(a[m][0][j]); s1[j] = fsigmoid(a[m][1][j]); }
              uint2 w0, w1; w0.x = pk2(s0[0], s0[1]); w0.y = pk2(s0[2], s0[3]); w1.x = pk2(s1[0], s1[1]); w1.y = pk2(s1[2], s1[3]);
              scr[((idx0 + m) * 2 + 0) * 512 + tid] = w0; scr[((idx0 + m) * 2 + 1) * 512 + tid] = w1;
            }
          } else {
#pragma unroll
            for (int mh = 0; mh < 4; mh += 2) {
              uint2 g0[2], g1[2], o0[2], o1[2];
#pragma unroll
              for (int m = 0; m < 2; ++m) { g0[m] = scr[((idx0 + mh + m) * 2 + 0) * 512 + tid]; g1[m] = scr[((idx0 + mh + m) * 2 + 1) * 512 + tid]; }
              if (x > 0) {
#pragma unroll
                for (int m = 0; m < 2; ++m) { const bf16_t* mp = p.merged + (size_t)(row0 + (mh + m) * 16) * 1024 + col; o0[m] = *(const uint2*)mp; o1[m] = *(const uint2*)(mp + 16); }
              }
#pragma unroll
              for (int m = 0; m < 2; ++m) {
                f32x4 v0 = a[mh + m][0], v1 = a[mh + m][1];
                const f32x4 s0 = {__uint_as_float(g0[m].x << 16), __uint_as_float(g0[m].x & 0xffff0000u), __uint_as_float(g0[m].y << 16), __uint_as_float(g0[m].y & 0xffff0000u)};
                const f32x4 s1 = {__uint_as_float(g1[m].x << 16), __uint_as_float(g1[m].x & 0xffff0000u), __uint_as_float(g1[m].y << 16), __uint_as_float(g1[m].y & 0xffff0000u)};
                v0 *= s0; v1 *= s1;
                if (x > 0) {
                  v0[0] += __uint_as_float(o0[m].x << 16); v0[1] += __uint_as_float(o0[m].x & 0xffff0000u); v0[2] += __uint_as_float(o0[m].y << 16); v0[3] += __uint_as_float(o0[m].y & 0xffff0000u);
                  v1[0] += __uint_as_float(o1[m].x << 16); v1[1] += __uint_as_float(o1[m].x & 0xffff0000u); v1[2] += __uint_as_float(o1[m].y << 16); v1[3] += __uint_as_float(o1[m].y & 0xffff0000u);
                }
                bf16_t* mp = p.merged + (size_t)(row0 + (mh + m) * 16) * 1024 + col;
                st4bf(mp, v0); st4bf(mp + 16, v1);
              }
              __builtin_amdgcn_sched_barrier(0);
            }
          } });
      }
    }
  }
  else {
    if ((int)blockIdx.x < 256) gemm_prologue(out_tile(wsb, blockIdx.x), shm);
    for (int t = blockIdx.x; t < 256; t += gridDim.x) {
      const int pm = TPM(t), pn = TPN(t);
      const int tn = t + gridDim.x; const bool hn = tn < 256;
      gemm256<false>(out_tile(wsb, t), hn, out_tile(wsb, hn ? tn : t), shm, [=](int ai, int bj, const f32x4 (&a)[4][2], int tid, int wr, int wc, int fr, int fq) {
        const int row0 = pm * 256 + ai * 128 + wr * 64 + fr; const int col = pn * 256 + bj * 128 + wc * 32 + fq * 4;
        const int b = row0 >> 12; const float* gt = p.mod + (l * 4 + b) * 3072 + 2048 + col;
#pragma unroll
        for (int mh = 0; mh < 4; mh += 2) {
          const f32x4 g0 = *(const f32x4*)gt, g1 = *(const f32x4*)(gt + 16);
          f32x4 x0[2], x1[2];
#pragma unroll
          for (int m = 0; m < 2; ++m) { const float* xi = xin + (size_t)(row0 + (mh + m) * 16) * 1024 + col; x0[m] = *(const f32x4*)xi; x1[m] = *(const f32x4*)(xi + 16); }
#pragma unroll
          for (int m = 0; m < 2; ++m) { float* xo = p.out + (size_t)(row0 + (mh + m) * 16) * 1024 + col; *(f32x4*)xo = x0[m] + g0 * a[mh + m][0]; *(f32x4*)(xo + 16) = x1[m] + g1 * a[mh + m][1]; }
          __builtin_amdgcn_sched_barrier(0);
        } });
    }
  }
}

DI Params make_params(const KArgs& k, char* w) {
  Params p;
  p.x = k.in[0]; p.c = k.in[1]; p.norm_g = k.in[2]; p.w_ada = k.in[3]; p.b_ada = k.in[4]; p.w_in = k.in[5]; p.sinks = k.in[6];
  p.w_br_a = k.in[7]; p.w_br_b = k.in[8]; p.w_br_c = k.in[9]; p.w_out = k.in[10]; p.final_g = k.in[11]; p.out = k.out;
  p.rope = (float2*)(w + OFF_ROPE); p.mod = (float*)(w + OFF_MOD); p.u = (bf16_t*)(w + OFF_U); p.wt_in = (bf16_t*)(w + OFF_WTIN); p.wt_br = (bf16_t*)(w + OFF_WTBR); p.wt_out = (bf16_t*)(w + OFF_WTOUT);
  p.zAq = (bf16_t*)(w + OFF_ZA); p.zAk = (bf16_t*)(w + OFF_ZA + 16 * MiB); p.zAv = (bf16_t*)(w + OFF_ZA + 32 * MiB); p.zAg = (bf16_t*)(w + OFF_ZA + 48 * MiB);
  p.zBq = (bf16_t*)(w + OFF_ZB); p.zCq = (bf16_t*)(w + OFF_ZB + 16 * MiB); p.zBk = (bf16_t*)(w + OFF_ZB + 32 * MiB); p.zBv = (bf16_t*)(w + OFF_ZB + 36 * MiB); p.zBg = (bf16_t*)(w + OFF_ZB + 40 * MiB);
  p.zCk = (bf16_t*)(w + OFF_ZB + 56 * MiB); p.zCv = (bf16_t*)(w + OFF_ZB + 72 * MiB); p.zCg = (bf16_t*)(w + OFF_ZB + 88 * MiB);
  p.iq = (bf16_t*)(w + OFF_IQ); p.ik = (bf16_t*)(w + OFF_IK); p.iw = (float*)(w + OFF_IW); p.bitmask = (unsigned*)(w + OFF_BM);
  p.sscr = (float*)p.zBk; p.merged = p.zAk; p.sigscr = p.zCk;
  return p;
}
template <bool COOP, int ONLY>
__global__ void __launch_bounds__(512) mega(KArgs ka, int ph_lo, int ph_hi) {
  extern __shared__ __attribute__((aligned(16))) char lds[];
  bool rep = false;
  XcdBarrier xb;
  if (COOP) {
    volatile LAS unsigned* st = (volatile LAS unsigned*)((LAS unsigned char*)lds + 131072);
    if (threadIdx.x < 4) st[threadIdx.x] = 0u;
    __syncthreads();
    xb = xcd_barrier_post((unsigned*)(ka.ws + OFF_BAR), st);
    if (ph_hi > 1000) cg::this_grid().sync();
  }
  for (int ph = ph_lo; ph < ph_hi; ++ph) {
    if (ONLY >= 0) { const int kind = (ph == 0) ? 7 : (ph == 15 ? 8 : (ph - 1) % 7); if (kind != ONLY) continue; }
    __attribute__((address_space(1))) char* wsp = (__attribute__((address_space(1))) char*)ka.ws; asm volatile("" : "+s"(wsp));
    const Params p = make_params(ka, (char*)wsp);
    run_phase(p, ph, lds);
    if (COOP && ph + 1 < ph_hi) { xcd_barrier(xb); }
    if (REP_HI >= 0 && ph >= 1 && ph < 15 && (ph - 1) % 7 == REP_HI) { if (!rep) { rep = true; ph -= (REP_HI - REP_LO + 1); } else rep = false; }
  }
}

extern "C" void kernel_launch(void* const* d_in, const int* in_sizes, int n_in, void* d_out, int out_size, void* d_ws, size_t ws_size, hipStream_t stream) {
  KArgs p{};
  for (int i = 0; i < 12; ++i) p.in[i] = (const float*)d_in[i];
  p.out = (float*)d_out; p.ws = (char*)d_ws;
  if (OFF_END > ws_size) { fprintf(stderr, "workspace too small: need %zu have %zu\n", (size_t)OFF_END, ws_size); return; }
#if USE_COOP
  (void)hipFuncSetAttribute((const void*)mega<true, -1>, hipFuncAttributeMaxDynamicSharedMemorySize, LDS_BYTES);
  (void)hipMemsetAsync((char*)d_ws + OFF_BAR, 0, 16384, stream);
  int lo = 0, hi = 16; void* args[] = {&p, &lo, &hi};
  hipError_t e = hipLaunchCooperativeKernel((void*)mega<true, -1>, dim3(256), dim3(512), args, LDS_BYTES, stream);
  if (e != hipSuccess) fprintf(stderr, "cooperative launch failed: %s\n", hipGetErrorString(e));
#else
#define LAUNCH_KIND(KD, ph) do { (void)hipFuncSetAttribute((const void*)mega<false, KD>, hipFuncAttributeMaxDynamicSharedMemorySize, LDS_BYTES); \
    hipLaunchKernelGGL((mega<false, KD>), dim3(256), dim3(512), LDS_BYTES, stream, p, ph, ph + 1); } while (0)
  LAUNCH_KIND(7, 0);
  for (int l = 0; l < 2; ++l) { const int b = 1 + 7 * l;
    LAUNCH_KIND(0, b); LAUNCH_KIND(1, b + 1); LAUNCH_KIND(2, b + 2); LAUNCH_KIND(3, b + 3); LAUNCH_KIND(4, b + 4); LAUNCH_KIND(5, b + 5); LAUNCH_KIND(6, b + 6); }
  LAUNCH_KIND(8, 15);
#endif
}
```

```cpp
#include <hip/hip_runtime.h>
#include <hip/hip_cooperative_groups.h>
#include <cstdio>
#include <cstdint>
namespace cg = cooperative_groups;

#ifndef SCORE_REP
#define SCORE_REP 1
#define SEL_REP 1
#endif
#ifndef ATT_REP_A
#define ATT_REP_A 1
#define ATT_REP_B 1
#define ATT_REP_C 1
#endif
#ifndef REP_LO
#define REP_LO -1
#define REP_HI -1
#endif
#ifndef USE_COOP
#define USE_COOP 1
#endif

typedef unsigned short bf16_t;
using bf16x8 = __attribute__((ext_vector_type(8))) short;
using f32x4 = __attribute__((ext_vector_type(4))) float;
using f32x16 = __attribute__((ext_vector_type(16))) float;
typedef float f32x2 __attribute__((ext_vector_type(2)));
typedef unsigned u32x4 __attribute__((ext_vector_type(4)));
typedef __bf16 nbf16x2 __attribute__((ext_vector_type(2)));
#define DI __device__ __forceinline__
DI int opaque_tid() { int t = threadIdx.x; asm volatile("" : "+v"(t)); return t; }

constexpr int DM = 1024, NBATCH = 4, SEQ = 4096, NTOK = NBATCH * SEQ, DIN = 8772;
constexpr int NT32 = SEQ / 32;
constexpr int WT_IN_ROWS = 8960;
constexpr int COL_IDX = 5376, COL_GATE = 5888;
constexpr int LDS_BYTES = 131072 + 16;
constexpr float C2 = 0.125f * 1.4426950408889634f;
constexpr float LOG2E = 1.4426950408889634f;

struct Params {
  const float *x, *c, *norm_g, *w_ada, *w_br_a, *b_ada, *w_br_b, *w_in, *sinks, *w_out, *w_br_c, *final_g;
  float* out;
  float2* rope;
  float* mod;
  bf16_t* u;
  bf16_t* wt_in;
  bf16_t* wt_br;
  bf16_t* wt_out;
  bf16_t *zAq, *zAk, *zAv, *zAg;
  bf16_t *zBq, *zBk, *zBv, *zBg;
  bf16_t *zCq, *zCk, *zCv, *zCg;
  bf16_t *iq, *ik;
  float* iw;
  unsigned* bitmask;
  float* sscr;
  bf16_t* merged;
  bf16_t* sigscr;
};

DI unsigned pk2(float a, float b) { f32x2 v = {a, b}; nbf16x2 r = __builtin_convertvector(v, nbf16x2); return __builtin_bit_cast(unsigned, r); }
DI float bf2f(bf16_t h) { return __uint_as_float(((unsigned)h) << 16); }
DI float wave_sum(float v) {
#pragma unroll
  for (int o = 32; o >= 1; o >>= 1) v += __shfl_xor(v, o);
  return v;
}
DI float fsigmoid(float x) { return __builtin_amdgcn_rcpf(1.0f + __builtin_amdgcn_exp2f(-1.4426950408889634f * x)); }

constexpr int BM = 256, BK = 64, HALF = 128, HT = HALF * BK;
DI int lds_byte(int r, int c) { int st = (r >> 4) * 2 + (c >> 5), rr = r & 15, cc = c & 31, ob = rr * 64 + cc * 2; return st * 1024 + (ob ^ (((ob >> 9) & 1) << 5)); }
DI void stage_rc(int b, int& R, int& C) { int st = b / 1024, sb = b % 1024, swz = sb ^ (((sb >> 9) & 1) << 5); R = (st >> 1) * 16 + swz / 64; C = (st & 1) * 32 + (swz % 64) / 2; }

#define LAS __attribute__((address_space(3)))
constexpr int HTB = HT * 2;
struct GemmTile { const bf16_t* A; const bf16_t* Bt; int K, brow, bcol; };
DI void gemm_prologue(const GemmTile g, LAS unsigned char* lds) {
  const int tid = opaque_tid(), wid = __builtin_amdgcn_readfirstlane(tid >> 6);
  const int K = g.K;
  unsigned voff[2];
#pragma unroll
  for (int i = 0; i < 2; ++i) { int R, C; stage_rc(tid * 16 + i * 8192, R, C); voff[i] = (unsigned)(R * K + C) * 2u; }
  const size_t kstep = (size_t)(BK * 2), hstep = (size_t)HALF * K * 2;
  const char* a0 = (const char*)(g.A + (size_t)g.brow * K);
  const char* b0 = (const char*)(g.Bt + (size_t)g.bcol * K);
  const unsigned ldsw = (unsigned)wid * 1024u;
#define SA(b, h) (((b)*2 + (h)) * HTB)
#define SB(b, h) ((4 + (b)*2 + (h)) * HTB)
#define STAGE(bufoff, gbase) do { _Pragma("unroll") for (int _i = 0; _i < 2; ++_i) \
    __builtin_amdgcn_global_load_lds((const unsigned*)((const char*)(gbase) + voff[_i]), (LAS unsigned*)(lds + (bufoff) + ldsw + _i * 8192), 16, 0, 0); } while (0)
  STAGE(SB(0, 0), b0); STAGE(SA(0, 0), a0);
  STAGE(SB(0, 1), b0 + hstep); STAGE(SA(0, 1), a0 + hstep);
  STAGE(SB(1, 0), b0 + kstep); STAGE(SA(1, 0), a0 + kstep); STAGE(SB(1, 1), b0 + hstep + kstep);
#undef SA
#undef SB
#undef STAGE
}
template <bool PER_M, class Epi>
DI void gemm256(const GemmTile g, const bool has_next, const GemmTile gn, LAS unsigned char* lds, Epi epi) {
  const bf16_t* __restrict__ A = g.A; const bf16_t* __restrict__ Bt = g.Bt; const int K = g.K, brow = g.brow, bcol = g.bcol;
  asm volatile("s_waitcnt vmcnt(0) lgkmcnt(0)" ::: "memory");
  __syncthreads();
  const int tid = opaque_tid(), wid = __builtin_amdgcn_readfirstlane(tid >> 6), lane = tid & 63, wr = wid >> 2, wc = wid & 3, fr = lane & 15, fq = lane >> 4;
  const int nt = K / BK;
  unsigned voff[2];
#pragma unroll
  for (int i = 0; i < 2; ++i) { int R, C; stage_rc(tid * 16 + i * 8192, R, C); voff[i] = (unsigned)(R * K + C) * 2u; }
  const size_t kstep = (size_t)(BK * 2), hstep = (size_t)HALF * K * 2;
  const char* a0 = (const char*)(A + (size_t)brow * K);
  const char* b0 = (const char*)(Bt + (size_t)bcol * K);
  const unsigned ldsw = (unsigned)wid * 1024u;
  const int aoff = lds_byte(wr * 64 + fr, fq * 8), boff = lds_byte(wc * 32 + fr, fq * 8);
#define SA(b, h) (((b)*2 + (h)) * HTB)
#define SB(b, h) ((4 + (b)*2 + (h)) * HTB)
#define STAGE(bufoff, gbase) do { _Pragma("unroll") for (int _i = 0; _i < 2; ++_i) \
    __builtin_amdgcn_global_load_lds((const unsigned*)((const char*)(gbase) + voff[_i]), (LAS unsigned*)(lds + (bufoff) + ldsw + _i * 8192), 16, 0, 0); } while (0)
#define LDA(dst, b, h) do { _Pragma("unroll") for (int m = 0; m < 4; ++m) _Pragma("unroll") for (int k = 0; k < 2; ++k) dst[m][k] = *(const LAS bf16x8*)(lds + SA(b, h) + aoff + m * 2048 + k * 1024); } while (0)
#define LDB(dst, b, h) do { _Pragma("unroll") for (int n = 0; n < 2; ++n) _Pragma("unroll") for (int k = 0; k < 2; ++k) dst[n][k] = *(const LAS bf16x8*)(lds + SB(b, h) + boff + n * 2048 + k * 1024); } while (0)
#define MMA(ai, bj, At_, Bt_) do { __builtin_amdgcn_s_setprio(1); _Pragma("unroll") for (int m = 0; m < 4; ++m) _Pragma("unroll") for (int n = 0; n < 2; ++n) _Pragma("unroll") for (int k = 0; k < 2; ++k) \
      acc[ai][bj][m][n] = __builtin_amdgcn_mfma_f32_16x16x32_bf16(Bt_[n][k], At_[m][k], acc[ai][bj][m][n], 0, 0, 0); \
    __builtin_amdgcn_s_setprio(0); } while (0)
#define WAIT_V(n) asm volatile("s_waitcnt vmcnt(" #n ")" ::: "memory")
#define WAIT_L(n) asm volatile("s_waitcnt lgkmcnt(" #n ")" ::: "memory")
#define BAR __builtin_amdgcn_s_barrier()
#define SCHED __builtin_amdgcn_sched_barrier(0)
  f32x4 acc[2][2][4][2];
#pragma unroll
  for (int a = 0; a < 2; ++a)
#pragma unroll
    for (int b = 0; b < 2; ++b)
#pragma unroll
      for (int m = 0; m < 4; ++m)
#pragma unroll
        for (int n = 0; n < 2; ++n) acc[a][b][m][n] = (f32x4){0.f, 0.f, 0.f, 0.f};
  bf16x8 At[4][2], B0[2][2], B1[2][2];
  if (wr == 1) BAR;
  BAR;
  BAR;
  for (int t = 0; t < nt - 2; t += 2) {
    const char* a1 = a0 + (size_t)(t + 1) * kstep; const char* a2 = a1 + kstep; const char* a3 = a2 + kstep;
    const char* b2 = b0 + (size_t)(t + 2) * kstep; const char* b3 = b2 + kstep;
    LDB(B0, 0, 0); SCHED; LDA(At, 0, 0); STAGE(SA(1, 1), a1 + hstep);
    WAIT_L(8); BAR; WAIT_L(0); MMA(0, 0, At, B0); BAR; SCHED;
    LDB(B1, 0, 1); STAGE(SB(0, 0), b2);
    BAR; WAIT_L(0); MMA(0, 1, At, B1); BAR;
    LDA(At, 0, 1); STAGE(SA(0, 0), a2);
    BAR; WAIT_L(0); MMA(1, 0, At, B0); BAR; SCHED;
    STAGE(SB(0, 1), b2 + hstep);
    WAIT_V(6); BAR; MMA(1, 1, At, B1); BAR;
    LDB(B0, 1, 0); SCHED; LDA(At, 1, 0); STAGE(SA(0, 1), a2 + hstep);
    WAIT_L(8); BAR; WAIT_L(0); MMA(0, 0, At, B0); BAR; SCHED;
    LDB(B1, 1, 1); STAGE(SB(1, 0), b3);
    BAR; WAIT_L(0); MMA(0, 1, At, B1); BAR;
    LDA(At, 1, 1); STAGE(SA(1, 0), a3);
    BAR; WAIT_L(0); MMA(1, 0, At, B0); BAR; SCHED;
    STAGE(SB(1, 1), b3 + hstep);
    WAIT_V(6); BAR; MMA(1, 1, At, B1); BAR;
  }
  { LDB(B0, 0, 0); LDA(At, 0, 0); STAGE(SA(1, 1), a0 + (size_t)(nt - 1) * kstep + hstep);
    BAR; WAIT_L(0); MMA(0, 0, At, B0); BAR;
    LDB(B1, 0, 1); BAR; WAIT_L(0); MMA(0, 1, At, B1); BAR;
    LDA(At, 0, 1); WAIT_V(4); BAR; WAIT_L(0); MMA(1, 0, At, B0); MMA(1, 1, At, B1); BAR; }
  { LDB(B0, 1, 0); LDA(At, 1, 0); WAIT_V(2); BAR; WAIT_L(0); MMA(0, 0, At, B0); BAR;
    LDB(B1, 1, 1); WAIT_V(0); BAR; WAIT_L(0); MMA(0, 1, At, B1); BAR;
    LDA(At, 1, 1); BAR; WAIT_L(0); MMA(1, 0, At, B0); MMA(1, 1, At, B1); BAR; }
  if (wr == 0) BAR;
  if (has_next) gemm_prologue(gn, lds);
  {
    int tid2 = opaque_tid();
    int wid2 = __builtin_amdgcn_readfirstlane(tid2 >> 6);
    const int lane2 = tid2 & 63, wr2 = wid2 >> 2, wc2 = wid2 & 3, fr2 = lane2 & 15, fq2 = lane2 >> 4;
#pragma unroll
    for (int ai = 0; ai < 2; ++ai)
#pragma unroll
      for (int bj = 0; bj < 2; ++bj) {
        if constexpr (PER_M) {
#pragma unroll
          for (int m = 0; m < 4; ++m) epi(ai, bj, m, acc[ai][bj][m][0], acc[ai][bj][m][1], tid2, wr2, wc2, fr2, fq2);
        } else {
          epi(ai, bj, acc[ai][bj], tid2, wr2, wc2, fr2, fq2);
        }
        SCHED;
      }
  }
#undef SA
#undef SB
#undef STAGE
#undef LDA
#undef LDB
#undef MMA
}

DI void rope4(f32x4& a, f32x4& b, const float2* __restrict__ tab, int pos, int d0) {
  const f32x4* tp = (const f32x4*)(tab + pos * 32 + d0);
  f32x4 t0 = tp[0], t1 = tp[1];
  float cs[4] = {t0[0], t0[2], t1[0], t1[2]}, sn[4] = {t0[1], t0[3], t1[1], t1[3]};
#pragma unroll
  for (int j = 0; j < 4; ++j) { float x1 = a[j], x2 = b[j]; a[j] = x1 * cs[j] - x2 * sn[j]; b[j] = x1 * sn[j] + x2 * cs[j]; }
}
DI void st4bf(bf16_t* p, f32x4 v) { uint2 w; w.x = pk2(v[0], v[1]); w.y = pk2(v[2], v[3]); *(uint2*)p = w; }
DI size_t kfrag_off(int bh, int pos, int d) { return ((size_t)bh * NT32 + (pos >> 5)) * 2048 + (size_t)(((d >> 4) * 64 + (pos & 31) + 32 * ((d >> 3) & 1)) * 8 + (d & 7)); }
DI size_t vfrag_off(int bh, int pos, int d) {
  int k32 = pos & 31, s = k32 >> 4, hi = (k32 >> 2) & 1, jj = ((k32 >> 3) & 1) * 4 + (k32 & 3);
  return ((size_t)bh * NT32 + (pos >> 5)) * 2048 + (size_t)((((d >> 5) * 2 + s) * 64 + (d & 31) + 32 * hi) * 8 + jj);
}
DI void st_vfrag(bf16_t* base, int bh, int pos, int d0, f32x4 v) {
  bf16_t* o = base + vfrag_off(bh, pos, d0);
  const unsigned w0 = pk2(v[0], v[1]), w1 = pk2(v[2], v[3]);
  o[0] = (bf16_t)(w0 & 0xffff); o[8] = (bf16_t)(w0 >> 16); o[16] = (bf16_t)(w1 & 0xffff); o[24] = (bf16_t)(w1 >> 16);
}
DI void st_vfrag2(bf16_t* o, f32x4 v) {
  const unsigned w0 = pk2(v[0], v[1]), w1 = pk2(v[2], v[3]);
  o[0] = (bf16_t)(w0 & 0xffff); o[8] = (bf16_t)(w0 >> 16); o[16] = (bf16_t)(w1 & 0xffff); o[24] = (bf16_t)(w1 >> 16);
}
DI f32x4 silu4(f32x4 v) { f32x4 r; for (int j = 0; j < 4; ++j) r[j] = v[j] * fsigmoid(v[j]); return r; }

DI void epi_main(const Params& p, int row, int G, int dlo, f32x4 v0, f32x4 v1) {
  const int b = row >> 12, pos = row & (SEQ - 1);
  if (G < 8) { rope4(v0, v1, p.rope, pos, dlo); bf16_t* o = p.zAq + (size_t)row * 512 + G * 64 + dlo; st4bf(o, v0); st4bf(o + 32, v1); }
  else if (G < 16) { rope4(v0, v1, p.rope, pos, dlo); int bh = b * 8 + (G - 8); { bf16_t* o = p.zAk + kfrag_off(bh, pos, dlo); st4bf(o, v0); st4bf(o + 1024, v1); } }
  else if (G < 24) { int bh = b * 8 + (G - 16); { bf16_t* o = p.zAv + vfrag_off(bh, pos, dlo); st_vfrag2(o, v0); st_vfrag2(o + 1024, v1); } }
  else if (G < 32) { bf16_t* o = p.zAg + (size_t)row * 512 + (G - 24) * 64 + dlo; st4bf(o, silu4(v0)); st4bf(o + 32, silu4(v1)); }
  else if (G < 40) { rope4(v0, v1, p.rope, pos, dlo); bf16_t* o = p.zBq + (size_t)row * 512 + (G - 32) * 64 + dlo; st4bf(o, v0); st4bf(o + 32, v1); }
  else if (G < 42) { rope4(v0, v1, p.rope, pos, dlo); int bh = b * 2 + (G - 40); { bf16_t* o = p.zBk + kfrag_off(bh, pos, dlo); st4bf(o, v0); st4bf(o + 1024, v1); } }
  else if (G < 44) { int bh = b * 2 + (G - 42); { bf16_t* o = p.zBv + vfrag_off(bh, pos, dlo); st_vfrag2(o, v0); st_vfrag2(o + 1024, v1); } }
  else if (G < 52) { bf16_t* o = p.zBg + (size_t)row * 512 + (G - 44) * 64 + dlo; st4bf(o, silu4(v0)); st4bf(o + 32, silu4(v1)); }
  else if (G < 60) { bf16_t* o = p.zCq + (size_t)row * 512 + (G - 52) * 64 + dlo; st4bf(o, v0); st4bf(o + 32, v1); }
  else if (G < 68) { int bh = b * 8 + (G - 60); { bf16_t* o = p.zCk + kfrag_off(bh, pos, dlo); st4bf(o, v0); st4bf(o + 1024, v1); } }
  else if (G < 76) { int bh = b * 8 + (G - 68); { bf16_t* o = p.zCv + vfrag_off(bh, pos, dlo); st_vfrag2(o, v0); st_vfrag2(o + 1024, v1); } }
  else { bf16_t* o = p.zCg + (size_t)row * 512 + (G - 76) * 64 + dlo; st4bf(o, silu4(v0)); st4bf(o + 32, silu4(v1)); }
}
DI void epi_idx(const Params& p, int row, int G, int dlo, f32x4 v0, f32x4 v1) {
  const int pos = row & (SEQ - 1);
  if (G < 4) { rope4(v0, v1, p.rope, pos, dlo); bf16_t* o = p.iq + (size_t)row * 256 + G * 64 + dlo; st4bf(o, v0); st4bf(o + 32, v1); }
  else if (G == 4) { rope4(v0, v1, p.rope, pos, dlo); bf16_t* o = p.ik + (size_t)row * 64 + dlo; st4bf(o, v0); st4bf(o + 32, v1); }
  else if (G == 5 && dlo == 0) { *(f32x4*)(p.iw + (size_t)row * 4) = v0 * 0.0625f; }
}

DI void phase_prep(const Params& p, char* lds) {
  const int tid = opaque_tid();
  for (int i = blockIdx.x * 512 + tid; i < SEQ * 32; i += gridDim.x * 512) {
    int pos = i >> 5, d = i & 31;
    float inv = 1.0f / powf(10000.0f, (float)d / 32.0f);
    float ang = (float)pos * inv;
    double xr = (double)ang * 0.15915494309189535; double fr = xr - rint(xr); float f = (float)fr;
    p.rope[i] = make_float2(__builtin_amdgcn_cosf(f), __builtin_amdgcn_sinf(f));
  }
  float* sl = (float*)lds; float* red = sl + 4096;
  for (int i = tid; i < 4096; i += 512) { float c = p.c[i]; sl[i] = c / (1.0f + expf(-c)); }
  __syncthreads();
  for (int unit = blockIdx.x; unit < 192; unit += gridDim.x) {
    const int l = unit / 96, n0 = (unit % 96) * 32, cn = tid & 31, kg = __builtin_amdgcn_readfirstlane(tid >> 6) * 2 + ((tid >> 5) & 1);
    const float* w = p.w_ada + (size_t)l * 1024 * 3072 + n0 + cn;
    float a0 = 0, a1 = 0, a2 = 0, a3 = 0;
    for (int k0 = kg * 64; k0 < kg * 64 + 64; k0 += 16) {
      float wv[16];
#pragma unroll
      for (int j = 0; j < 16; ++j) wv[j] = w[(size_t)(k0 + j) * 3072];
#pragma unroll
      for (int j = 0; j < 16; ++j) { a0 += sl[k0 + j] * wv[j]; a1 += sl[1024 + k0 + j] * wv[j]; a2 += sl[2048 + k0 + j] * wv[j]; a3 += sl[3072 + k0 + j] * wv[j]; }
    }
    red[(kg * 4 + 0) * 32 + cn] = a0; red[(kg * 4 + 1) * 32 + cn] = a1; red[(kg * 4 + 2) * 32 + cn] = a2; red[(kg * 4 + 3) * 32 + cn] = a3;
    __syncthreads();
    if (tid < 128) { const int b = tid >> 5; float sm = 0; for (int g = 0; g < 16; ++g) sm += red[(g * 4 + b) * 32 + cn]; p.mod[(l * 4 + b) * 3072 + n0 + cn] = sm + p.b_ada[l * 3072 + n0 + cn]; }
    __syncthreads();
  }
}

DI int wt_in_src_col(int np) {
  if (np >= COL_GATE) return np - COL_GATE + 5700;
  int c64 = np & 63; int d = ((c64 >> 5) & 1) * 16 + (c64 & 15) + ((c64 >> 4) & 1) * 32; int L = (np & ~63) + d;
  if (L < 2048) return L;
  if (L < COL_IDX) return L + 324;
  int q = L - COL_IDX; return q < 324 ? 2048 + q : -1;
}
struct WtTile { const float* src; bf16_t* dst; int lds_src, K, np0, k0, mode; };
DI WtTile wt_decode(const Params& p, int l, int t) {
  WtTile w;
  if (t < 1120) { w.k0 = (t & 7) * 128; w.np0 = (t >> 3) * 64; w.src = p.w_in + (size_t)l * 1024 * DIN; w.lds_src = DIN; w.K = 1024; w.dst = p.wt_in; w.mode = 0; }
  else if (t < 1312) { const int q = t - 1120, x = q >> 6, r = q & 63; w.k0 = (r & 3) * 128; w.np0 = (r >> 2) * 64;
    const float* wa_ = p.w_br_a; const float* wb_ = p.w_br_b; const float* wc_ = p.w_br_c; asm volatile("" : "+s"(wa_), "+s"(wb_), "+s"(wc_));
    const float* wb = x == 0 ? wa_ : (x == 1 ? wb_ : wc_); w.src = wb + (size_t)l * 512 * 1024; w.lds_src = 1024; w.K = 512; w.dst = p.wt_br + (size_t)x * 1024 * 512; w.mode = 1; }
  else { const int q = t - 1312; w.k0 = (q & 7) * 128; w.np0 = (q >> 3) * 64; w.src = p.w_out + (size_t)l * 1024 * 1024; w.lds_src = 1024; w.K = 1024; w.dst = p.wt_out; w.mode = 1; }
  return w;
}
DI void phase_a(const Params& p, int l, const float* xin, char* lds) {
  const int tid = opaque_tid(), lane = tid & 63, wave = __builtin_amdgcn_readfirstlane(tid >> 6);
  for (int row0 = (blockIdx.x * 8 + wave) * 4; row0 < NTOK; row0 += gridDim.x * 32) {
    f32x4 v[4][4]; float ss[4] = {0.f, 0.f, 0.f, 0.f};
#pragma unroll
    for (int r = 0; r < 4; ++r)
#pragma unroll
      for (int i = 0; i < 4; ++i) v[r][i] = *(const f32x4*)(xin + (size_t)(row0 + r) * 1024 + i * 256 + lane * 4);
    const int b = row0 >> 12;
    const float* md = p.mod + (l * 4 + b) * 3072;
    f32x4 gg[4], shh[4], scc[4];
#pragma unroll
    for (int i = 0; i < 4; ++i) { const int col = i * 256 + lane * 4; gg[i] = *(const f32x4*)(p.norm_g + l * 1024 + col); shh[i] = *(const f32x4*)(md + col); scc[i] = *(const f32x4*)(md + 1024 + col); }
#pragma unroll
    for (int r = 0; r < 4; ++r) {
#pragma unroll
      for (int i = 0; i < 4; ++i) ss[r] += v[r][i][0] * v[r][i][0] + v[r][i][1] * v[r][i][1] + v[r][i][2] * v[r][i][2] + v[r][i][3] * v[r][i][3];
      ss[r] = wave_sum(ss[r]);
    }
#pragma unroll
    for (int i = 0; i < 4; ++i) {
      int col = i * 256 + lane * 4;
      const f32x4 g = gg[i], sh = shh[i], sc = scc[i];
#pragma unroll
      for (int r = 0; r < 4; ++r) {
        const float rstd = rsqrtf(ss[r] * (1.0f / 1024.0f) + 1e-6f);
        f32x4 uu; for (int j = 0; j < 4; ++j) uu[j] = v[r][i][j] * rstd * g[j] * (1.0f + sc[j]) + sh[j];
        st4bf(p.u + (size_t)(row0 + r) * 1024 + col, uu);
      }
    }
  }
  float* tile = (float*)lds;
  const int kk = tid >> 4, c4 = (tid & 15) * 4;
  f32x4 val[4];
  int t = blockIdx.x;
  if (t < 1440) { WtTile w = wt_decode(p, l, t); const int ncol = w.mode == 0 ? wt_in_src_col(w.np0 + c4) : w.np0 + c4;
#pragma unroll
    for (int it = 0; it < 4; ++it) { val[it] = (f32x4){0.f, 0.f, 0.f, 0.f}; if (ncol >= 0) val[it] = *(const f32x4*)(w.src + (size_t)(w.k0 + kk + it * 32) * w.lds_src + ncol); } }
  for (; t < 1440; t += gridDim.x) {
    const WtTile w = wt_decode(p, l, t);
    f32x4 nval[4];
    const int tn = t + gridDim.x;
    if (tn < 1440) { const WtTile wn = wt_decode(p, l, tn); const int ncoln = wn.mode == 0 ? wt_in_src_col(wn.np0 + c4) : wn.np0 + c4;
#pragma unroll
      for (int it = 0; it < 4; ++it) { nval[it] = (f32x4){0.f, 0.f, 0.f, 0.f}; if (ncoln >= 0) nval[it] = *(const f32x4*)(wn.src + (size_t)(wn.k0 + kk + it * 32) * wn.lds_src + ncoln); } }
#pragma unroll
    for (int it = 0; it < 4; ++it) {
      const int k = kk + it * 32;
      tile[k * 65 + c4 + 0] = val[it][0]; tile[k * 65 + c4 + 1] = val[it][1]; tile[k * 65 + c4 + 2] = val[it][2]; tile[k * 65 + c4 + 3] = val[it][3];
    }
    __syncthreads();
    { const int nn = tid >> 3, k16 = (tid & 7) * 16;
#pragma unroll
      for (int h2 = 0; h2 < 2; ++h2) { const int k8 = k16 + h2 * 8; uint4 ww;
        ww.x = pk2(tile[(k8 + 0) * 65 + nn], tile[(k8 + 1) * 65 + nn]); ww.y = pk2(tile[(k8 + 2) * 65 + nn], tile[(k8 + 3) * 65 + nn]);
        ww.z = pk2(tile[(k8 + 4) * 65 + nn], tile[(k8 + 5) * 65 + nn]); ww.w = pk2(tile[(k8 + 6) * 65 + nn], tile[(k8 + 7) * 65 + nn]);
        *(uint4*)(w.dst + (size_t)(w.np0 + nn) * w.K + w.k0 + k8) = ww; } }
    __syncthreads();
#pragma unroll
    for (int it = 0; it < 4; ++it) val[it] = nval[it];
  }
}

DI void cnt8(unsigned k0, unsigned k1, unsigned k2, unsigned k3, unsigned k4, unsigned k5, unsigned k6, unsigned k7, unsigned cand, int& lacc) {
  unsigned long long m0, m1, m2, m3, m4, m5, m6, m7, t0;
  asm("v_cmp_ge_u32_e64 %0, %10, %18\n\tv_cmp_ge_u32_e64 %1, %11, %18\n\tv_cmp_ge_u32_e64 %2, %12, %18\n\tv_cmp_ge_u32_e64 %3, %13, %18\n\t"
      "v_cmp_ge_u32_e64 %4, %14, %18\n\tv_cmp_ge_u32_e64 %5, %15, %18\n\tv_cmp_ge_u32_e64 %6, %16, %18\n\tv_cmp_ge_u32_e64 %7, %17, %18\n\t"
      "v_addc_co_u32_e64 %9, %8, 0, %9, %0\n\tv_addc_co_u32_e64 %9, %8, 0, %9, %1\n\tv_addc_co_u32_e64 %9, %8, 0, %9, %2\n\tv_addc_co_u32_e64 %9, %8, 0, %9, %3\n\t"
      "v_addc_co_u32_e64 %9, %8, 0, %9, %4\n\tv_addc_co_u32_e64 %9, %8, 0, %9, %5\n\tv_addc_co_u32_e64 %9, %8, 0, %9, %6\n\tv_addc_co_u32_e64 %9, %8, 0, %9, %7"
      : "=&s"(m0), "=&s"(m1), "=&s"(m2), "=&s"(m3), "=&s"(m4), "=&s"(m5), "=&s"(m6), "=&s"(m7), "=&s"(t0), "+v"(lacc)
      : "v"(k0), "v"(k1), "v"(k2), "v"(k3), "v"(k4), "v"(k5), "v"(k6), "v"(k7), "s"(cand));
}
DI int wave_total(int v) {
  v += __builtin_amdgcn_mov_dpp(v, 0xB1, 0xF, 0xF, true);
  v += __builtin_amdgcn_mov_dpp(v, 0x4E, 0xF, 0xF, true);
  v += __builtin_amdgcn_mov_dpp(v, 0x124, 0xF, 0xF, true);
  v += __builtin_amdgcn_mov_dpp(v, 0x128, 0xF, 0xF, true);
  return (__builtin_amdgcn_readlane(v, 0) + __builtin_amdgcn_readlane(v, 16)) + (__builtin_amdgcn_readlane(v, 32) + __builtin_amdgcn_readlane(v, 48));
}
DI int count_ge(const unsigned (&key)[64], unsigned cand, int nj) {
  int lacc = 0;
  const int ng = __builtin_amdgcn_readfirstlane((nj + 7) >> 3);
#pragma unroll
  for (int g = 0; g < 8; ++g) {
    if (g < ng) cnt8(key[g * 8], key[g * 8 + 1], key[g * 8 + 2], key[g * 8 + 3], key[g * 8 + 4], key[g * 8 + 5], key[g * 8 + 6], key[g * 8 + 7], cand, lacc);
  }
  return wave_total(lacc);
}
DI void phase_score_select(const Params& p) {
  const int tid = opaque_tid(), lane = tid & 63, wave = __builtin_amdgcn_readfirstlane(tid >> 6);
  float* sc = p.sscr + (size_t)blockIdx.x * (16 * 4096);
  for (int unit = blockIdx.x; unit < NTOK / 16; unit += gridDim.x) {
    const int b = unit & 3, kq = unit / (int)gridDim.x, jq = (unit % (int)gridDim.x) >> 2;
    const int strip = (gridDim.x == 256) ? (kq == 0 ? 255 - jq : (kq == 1 ? 128 + jq : (kq == 2 ? 127 - jq : jq))) : 255 - (unit >> 2);
    const int t0 = strip * 16;
    const size_t tokb = (size_t)b * SEQ;
    {
      bf16x8 aq[4][2];
#pragma unroll
      for (int hd = 0; hd < 4; ++hd)
#pragma unroll
        for (int c = 0; c < 2; ++c) aq[hd][c] = *(const bf16x8*)(p.iq + (tokb + t0 + (lane & 15)) * 256 + hd * 64 + c * 32 + (lane >> 4) * 8);
      f32x4 wts[4];
#pragma unroll
      for (int i = 0; i < 4; ++i) wts[i] = *(const f32x4*)(p.iw + (tokb + t0 + (lane >> 4) * 4 + i) * 4);
      for (int rep_ = 0; rep_ < SCORE_REP; ++rep_)
      for (int kt = wave; kt <= (strip | 3); kt += 8) {
        bf16x8 bk[2];
#pragma unroll
        for (int c = 0; c < 2; ++c) bk[c] = *(const bf16x8*)(p.ik + (tokb + kt * 16 + (lane & 15)) * 64 + c * 32 + (lane >> 4) * 8);
        f32x4 s = {0.f, 0.f, 0.f, 0.f};
#pragma unroll
        for (int hd = 0; hd < 4; ++hd) {
          f32x4 a = {0.f, 0.f, 0.f, 0.f};
          a = __builtin_amdgcn_mfma_f32_16x16x32_bf16(aq[hd][0], bk[0], a, 0, 0, 0);
          a = __builtin_amdgcn_mfma_f32_16x16x32_bf16(aq[hd][1], bk[1], a, 0, 0, 0);
#pragma unroll
          for (int i = 0; i < 4; ++i) s[i] += wts[i][hd] * fmaxf(a[i], 0.f);
        }
        const int key = kt * 16 + (lane & 15);
#pragma unroll
        for (int i = 0; i < 4; ++i) { int q = (lane >> 4) * 4 + i; sc[q * 4096 + key] = (key <= t0 + q) ? (s[i] + 0.0f) : -INFINITY; }
      }
    }
    __threadfence_block();
    __syncthreads();
    for (int rep_ = 0; rep_ < SEL_REP; ++rep_)
    for (int q = wave; q < 16; q += 8) {
      const int t = t0 + q; const int nj = (t >> 6) + 1;
      unsigned key[64];
      {
        const float* rowp = sc + q * 4096;
        int vv[64];
#pragma unroll
        for (int j = 0; j < 64; ++j) vv[j] = (j < nj) ? __float_as_int(rowp[j * 64 + lane]) : (int)0xff800000u;
        __builtin_amdgcn_sched_barrier(0);
#pragma unroll
        for (int j = 0; j < 64; ++j) key[j] = (unsigned)vv[j] ^ ((unsigned)(vv[j] >> 31) | 0x80000000u);
      }
      unsigned T = 0x00800000u; bool fast = true; int need = 0;
      if (t + 1 > 256) {
        T = 0; bool found = false;
        for (int bit = 31; bit >= 0; --bit) {
          unsigned cand = T | (1u << bit); int c = count_ge(key, cand, nj);
          if (c >= 256) { T = cand; if (c == 256) { found = true; break; } }
        }
        if (!found) { fast = false; int cgt = (T == 0xFFFFFFFFu) ? 0 : count_ge(key, T + 1, nj); need = 256 - cgt; }
      }
      unsigned long long myword = 0ull;
      if (fast) {
#pragma unroll
        for (int j = 0; j < 64; ++j) { unsigned long long sm = __ballot(key[j] >= T); if (lane == j) myword = sm; }
      } else {
        int run = 0;
#pragma unroll
        for (int j = 0; j < 64; ++j) {
          unsigned long long eqm = __ballot(key[j] == T);
          int pre = __builtin_amdgcn_mbcnt_hi((unsigned)(eqm >> 32), __builtin_amdgcn_mbcnt_lo((unsigned)eqm, 0u));
          bool sel = (key[j] > T) || (key[j] == T && (run + pre) < need);
          unsigned long long sm = __ballot(sel);
          run += __popcll(eqm);
          if (lane == j) myword = sm;
          __builtin_amdgcn_sched_barrier(0);
        }
      }
      ((unsigned long long*)p.bitmask)[(tokb + t) * 64 + lane] = myword;
    }
    __syncthreads();
  }
}

DI int crow(int r, int hi) { return (r & 3) + 8 * (r >> 2) + 4 * hi; }
#define MFMA32(a, b, c) __builtin_amdgcn_mfma_f32_32x32x16_bf16(a, b, c, 0, 0, 0)
DI bf16x8 pack_step(const f32x16& x, int s) {
  uint4 w; w.x = pk2(x[8 * s], x[8 * s + 1]); w.y = pk2(x[8 * s + 2], x[8 * s + 3]); w.z = pk2(x[8 * s + 4], x[8 * s + 5]); w.w = pk2(x[8 * s + 6], x[8 * s + 7]);
  return __builtin_bit_cast(bf16x8, w);
}
DI float swap_max(float m) { auto rr = __builtin_amdgcn_permlane32_swap(__float_as_uint(m), __float_as_uint(m), false, false); return fmaxf(__uint_as_float(rr[0]), __uint_as_float(rr[1])); }

template <int MODE>
DI void attn_wave(const Params& p, int l, int b, int h, int qblk, bool do_store) {
  const int lane = opaque_tid() & 63, r32 = lane & 31, hi = lane >> 5;
  const int q0 = qblk * 32, t = q0 + r32;
  const size_t tok = (size_t)b * SEQ + t;
  bf16_t* Q; const bf16_t *Kb, *Vb, *Gt; int bh;
  if (MODE == 0) { Q = p.zAq; bh = b * 8 + h; Kb = p.zAk; Vb = p.zAv; Gt = p.zAg; }
  else if (MODE == 1) { Q = p.zBq; bh = b * 2 + (h >> 2); Kb = p.zBk; Vb = p.zBv; Gt = p.zBg; }
  else { Q = p.zCq; bh = b * 8 + h; Kb = p.zCk; Vb = p.zCv; Gt = p.zCg; }
  Kb += (size_t)bh * NT32 * 2048; Vb += (size_t)bh * NT32 * 2048;
  bf16_t* qp = Q + tok * 512 + h * 64;
  bf16x8 qr[4];
#pragma unroll
  for (int d0 = 0; d0 < 4; ++d0) qr[d0] = *(const bf16x8*)(qp + d0 * 16 + hi * 8);
  const bf16_t* gp = Gt + tok * 512 + h * 64;
  uint2 gwv[2][4];
#pragma unroll
  for (int dt = 0; dt < 2; ++dt)
#pragma unroll
    for (int rq = 0; rq < 4; ++rq) gwv[dt][rq] = *(const uint2*)(gp + dt * 32 + 8 * rq + 4 * hi);
  f32x16 o0 = {}, o1 = {};
  float m = -1e30f, lsum = 0.f, carry = 1.0f;
  int kt_lo = 0, kt_hi = (q0 + 31) >> 6;
  if (MODE == 1) { int lo = q0 - 127; kt_lo = lo > 0 ? (lo >> 6) : 0; m = p.sinks[l * 8 + h] * LOG2E; lsum = hi == 0 ? 1.0f : 0.0f; }
  if (MODE == 2) { kt_hi = q0 > 0 ? ((q0 + 30) >> 6) : 0; }
  const unsigned* bmrow = p.bitmask + tok * 128;
  bf16x8 kf[2][4], vf[2][4];
  { const int kt = (MODE == 2) ? kt_hi : kt_lo;
    const bf16_t* kp = Kb + (size_t)kt * 4096 + lane * 8; const bf16_t* vp = Vb + (size_t)kt * 4096 + lane * 8;
#pragma unroll
    for (int kh = 0; kh < 2; ++kh)
#pragma unroll
      for (int d0 = 0; d0 < 4; ++d0) { kf[kh][d0] = *(const bf16x8*)(kp + kh * 2048 + d0 * 512); vf[kh][d0] = *(const bf16x8*)(vp + kh * 2048 + d0 * 512); } }
  for (int it = 0; it <= kt_hi - kt_lo; ++it) {
    const int kt = (MODE == 2) ? (kt_hi - it) : (kt_lo + it);
    const bool has_nx = it < kt_hi - kt_lo;
    const int ktn = has_nx ? ((MODE == 2) ? kt - 1 : kt + 1) : kt;
    f32x16 p0 = {}, p1 = {};
#pragma unroll
    for (int d0 = 0; d0 < 4; ++d0) { p0 = MFMA32(kf[0][d0], qr[d0], p0); p1 = MFMA32(kf[1][d0], qr[d0], p1); }
    if (has_nx) { const bf16_t* kp = Kb + (size_t)ktn * 4096 + lane * 8;
#pragma unroll
      for (int kh = 0; kh < 2; ++kh)
#pragma unroll
        for (int d0 = 0; d0 < 4; ++d0) kf[kh][d0] = *(const bf16x8*)(kp + kh * 2048 + d0 * 512); }
    const int kbase = kt * 64 + 4 * hi;
    if (MODE == 0 || MODE == 1) {
      unsigned w0 = 0xffffffffu, w1 = 0xffffffffu;
      if (MODE == 0) { uint2 ww = *(const uint2*)(bmrow + kt * 2); w0 = ww.x >> (4 * hi); w1 = ww.y >> (4 * hi); }
      float mx = -INFINITY;
#pragma unroll
      for (int r = 0; r < 16; ++r) {
        const int bit = (r & 3) + 8 * (r >> 2);
        bool v0, v1;
        if (MODE == 0) { v0 = (w0 >> bit) & 1u; v1 = (w1 >> bit) & 1u; }
        else { int k0 = kbase + bit, k1 = k0 + 32; v0 = (k0 <= t) && (k0 > t - 128); v1 = (k1 <= t) && (k1 > t - 128); }
        p0[r] = v0 ? p0[r] * C2 : -INFINITY; p1[r] = v1 ? p1[r] * C2 : -INFINITY;
        mx = fmaxf(mx, fmaxf(p0[r], p1[r]));
      }
      mx = swap_max(mx);
      const float mn = fmaxf(m, mx), alpha = __builtin_amdgcn_exp2f(m - mn);
      m = mn; float ps = 0.f;
#pragma unroll
      for (int r = 0; r < 16; ++r) { p0[r] = __builtin_amdgcn_exp2f(p0[r] - mn); p1[r] = __builtin_amdgcn_exp2f(p1[r] - mn); ps += p0[r] + p1[r]; }
      lsum = lsum * alpha + ps;
#pragma unroll
      for (int r = 0; r < 16; ++r) { o0[r] *= alpha; o1[r] *= alpha; }
    } else {
      float Gs[16];
#pragma unroll
      for (int kh = 0; kh < 2; ++kh) {
#pragma unroll
        for (int rq = 0; rq < 4; ++rq) {
          float be[4], rr[4];
#pragma unroll
          for (int i = 0; i < 4; ++i) {
            const int r = rq * 4 + i; const int key = kbase + kh * 32 + (r & 3) + 8 * (r >> 2);
            float sv = kh == 0 ? p0[r] : p1[r];
            float e = __builtin_amdgcn_exp2f(fminf(sv * C2, 80.f));
            float rc = __builtin_amdgcn_rcpf(1.0f + e);
            bool valid = key < t;
            be[i] = valid ? e * rc : 0.f; rr[i] = valid ? rc : 1.0f;
          }
          float s2 = rr[3], s1 = s2 * rr[2], s0 = s1 * rr[1], G = s0 * rr[0];
          float a0 = be[0] * s0, a1 = be[1] * s1, a2 = be[2] * s2, a3 = be[3];
          if (kh == 0) { p0[rq * 4] = a0; p0[rq * 4 + 1] = a1; p0[rq * 4 + 2] = a2; p0[rq * 4 + 3] = a3; }
          else { p1[rq * 4] = a0; p1[rq * 4 + 1] = a1; p1[rq * 4 + 2] = a2; p1[rq * 4 + 3] = a3; }
          auto sw = __builtin_amdgcn_permlane32_swap(__float_as_uint(G), __float_as_uint(G), false, false);
          Gs[kh * 8 + rq * 2] = __uint_as_float(sw[0]); Gs[kh * 8 + rq * 2 + 1] = __uint_as_float(sw[1]);
        }
      }
      float E[16]; E[15] = carry;
#pragma unroll
      for (int g = 14; g >= 0; --g) E[g] = E[g + 1] * Gs[g + 1];
      carry = E[0] * Gs[0];
#pragma unroll
      for (int kh = 0; kh < 2; ++kh)
#pragma unroll
        for (int rq = 0; rq < 4; ++rq) {
          float ev = hi ? E[kh * 8 + rq * 2 + 1] : E[kh * 8 + rq * 2];
#pragma unroll
          for (int i = 0; i < 4; ++i) { if (kh == 0) p0[rq * 4 + i] *= ev; else p1[rq * 4 + i] *= ev; }
        }
    }
#pragma unroll
    for (int s = 0; s < 2; ++s) {
      bf16x8 pa = pack_step(p0, s), pb = pack_step(p1, s);
      o0 = MFMA32(vf[0][0 * 2 + s], pa, o0); o1 = MFMA32(vf[0][1 * 2 + s], pa, o1);
      o0 = MFMA32(vf[1][0 * 2 + s], pb, o0); o1 = MFMA32(vf[1][1 * 2 + s], pb, o1);
    }
    if (MODE == 2) { if (__ballot(carry > 1e-20f) == 0ull) break; }
    if (has_nx) { const bf16_t* vp = Vb + (size_t)ktn * 4096 + lane * 8;
#pragma unroll
      for (int kh = 0; kh < 2; ++kh)
#pragma unroll
        for (int d0 = 0; d0 < 4; ++d0) vf[kh][d0] = *(const bf16x8*)(vp + kh * 2048 + d0 * 512); }
  }
  float inv = 1.0f;
  if (MODE != 2) { auto rr = __builtin_amdgcn_permlane32_swap(__float_as_uint(lsum), __float_as_uint(lsum), false, false); inv = 1.0f / (__uint_as_float(rr[0]) + __uint_as_float(rr[1])); }
#pragma unroll
  for (int dt = 0; dt < 2; ++dt)
#pragma unroll
    for (int rq = 0; rq < 4; ++rq) {
      const int d = dt * 32 + 8 * rq + 4 * hi;
      const uint2 gw = gwv[dt][rq];
      f32x4 v;
#pragma unroll
      for (int i = 0; i < 4; ++i) v[i] = (dt == 0 ? o0[rq * 4 + i] : o1[rq * 4 + i]) * inv;
      v[0] *= __uint_as_float(gw.x << 16); v[1] *= __uint_as_float(gw.x & 0xffff0000u); v[2] *= __uint_as_float(gw.y << 16); v[3] *= __uint_as_float(gw.y & 0xffff0000u);
      if (do_store) st4bf(qp + d, v);
    }
}
DI void attn_A_wg(const Params& p, int b, int h, int g, LAS unsigned char* lds, bool do_store) {
  const int tid = opaque_tid(), lane = tid & 63, wave = __builtin_amdgcn_readfirstlane(tid >> 6), r32 = lane & 31, hi = lane >> 5;
  const int qblk = g * 8 + wave, q0 = qblk * 32, t = q0 + r32;
  const size_t tok = (size_t)b * SEQ + t;
  const int bh = b * 8 + h;
  bf16_t* qp = p.zAq + tok * 512 + h * 64;
  bf16x8 qr[4];
#pragma unroll
  for (int d0 = 0; d0 < 4; ++d0) qr[d0] = *(const bf16x8*)(qp + d0 * 16 + hi * 8);
  const u32x4* kg = (const u32x4*)(p.zAk + (size_t)bh * NT32 * 2048) + tid;
  const u32x4* vg = (const u32x4*)(p.zAv + (size_t)bh * NT32 * 2048) + tid;
  const int kt_end = 4 * g + 3, my_hi = (q0 + 31) >> 6;
  const unsigned* bmrow = p.bitmask + tok * 128;
  f32x16 o0 = {}, o1 = {};
  float m = -1e30f, lsum = 0.f;
  __syncthreads();
  { u32x4 rk = kg[0], rv = vg[0];
    *(LAS u32x4*)(lds + tid * 16) = rk; *(LAS u32x4*)(lds + 8192 + tid * 16) = rv; }
  __syncthreads();
  uint2 ww_nxt = *(const uint2*)bmrow;
  for (int kt = 0; kt <= kt_end; ++kt) {
    u32x4 rk, rv;
    if (kt < kt_end) { rk = kg[(size_t)(kt + 1) * 512]; rv = vg[(size_t)(kt + 1) * 512]; }
    const uint2 ww = ww_nxt;
    if (kt + 1 <= my_hi) ww_nxt = *(const uint2*)(bmrow + (kt + 1) * 2);
    if (kt <= my_hi) {
      LAS unsigned char* kb = lds + (kt & 1) * 16384 + lane * 16;
      LAS unsigned char* vb = kb + 8192;
      bf16x8 kf[8], vf[8];
#pragma unroll
      for (int i = 0; i < 8; ++i) kf[i] = *(const LAS bf16x8*)(kb + i * 1024);
#pragma unroll
      for (int i = 0; i < 8; ++i) vf[i] = *(const LAS bf16x8*)(vb + i * 1024);
      f32x16 p0 = {}, p1 = {};
#pragma unroll
      for (int d0 = 0; d0 < 4; ++d0) { p0 = MFMA32(kf[d0], qr[d0], p0); p1 = MFMA32(kf[4 + d0], qr[d0], p1); }
      float mx = fmaxf(p0[0], p1[0]);
#pragma unroll
      for (int r = 1; r < 16; ++r) mx = fmaxf(mx, fmaxf(p0[r], p1[r]));
      mx = swap_max(mx) * C2;
      const float mn = fmaxf(m, mx);
      if (__builtin_amdgcn_ballot_w64(mn - m > 8.0f) != 0ull) {
        const float alpha = __builtin_amdgcn_exp2f(m - mn);
        lsum *= alpha;
#pragma unroll
        for (int r = 0; r < 16; ++r) { o0[r] *= alpha; o1[r] *= alpha; }
        m = mn;
      }
      const int w0 = (int)(ww.x >> (4 * hi)), w1 = (int)(ww.y >> (4 * hi));
      const f32x2 nm2 = {-m, -m}, c22 = {C2, C2};
      f32x2 ps2 = {0.f, 0.f};
#pragma unroll
      for (int r = 0; r < 16; r += 2) {
        const int bit0 = (r & 3) + 8 * (r >> 2), bit1 = bit0 + 1;
        const f32x2 a0 = (f32x2){p0[r], p0[r + 1]} * c22 + nm2, a1 = (f32x2){p1[r], p1[r + 1]} * c22 + nm2;
        f32x2 e0, e1;
        e0.x = __uint_as_float(__float_as_uint(__builtin_amdgcn_exp2f(a0.x)) & (unsigned)__builtin_amdgcn_sbfe(w0, bit0, 1));
        e0.y = __uint_as_float(__float_as_uint(__builtin_amdgcn_exp2f(a0.y)) & (unsigned)__builtin_amdgcn_sbfe(w0, bit1, 1));
        e1.x = __uint_as_float(__float_as_uint(__builtin_amdgcn_exp2f(a1.x)) & (unsigned)__builtin_amdgcn_sbfe(w1, bit0, 1));
        e1.y = __uint_as_float(__float_as_uint(__builtin_amdgcn_exp2f(a1.y)) & (unsigned)__builtin_amdgcn_sbfe(w1, bit1, 1));
        p0[r] = e0.x; p0[r + 1] = e0.y; p1[r] = e1.x; p1[r + 1] = e1.y;
        ps2 += e0 + e1;
      }
      const float ps = ps2.x + ps2.y;
      lsum += ps;
#pragma unroll
      for (int s2 = 0; s2 < 2; ++s2) {
        bf16x8 pa = pack_step(p0, s2), pb = pack_step(p1, s2);
        o0 = MFMA32(vf[0 * 2 + s2], pa, o0); o1 = MFMA32(vf[1 * 2 + s2], pa, o1);
        o0 = MFMA32(vf[4 + 0 * 2 + s2], pb, o0); o1 = MFMA32(vf[4 + 1 * 2 + s2], pb, o1);
      }
    }
    if (kt < kt_end) { LAS unsigned char* nb = lds + ((kt + 1) & 1) * 16384 + tid * 16; *(LAS u32x4*)nb = rk; *(LAS u32x4*)(nb + 8192) = rv; }
    __syncthreads();
  }
  auto rr = __builtin_amdgcn_permlane32_swap(__float_as_uint(lsum), __float_as_uint(lsum), false, false);
  const float inv = 1.0f / (__uint_as_float(rr[0]) + __uint_as_float(rr[1]));
  const bf16_t* gp = p.zAg + tok * 512 + h * 64;
#pragma unroll
  for (int dt = 0; dt < 2; ++dt)
#pragma unroll
    for (int rq = 0; rq < 4; ++rq) {
      const int d = dt * 32 + 8 * rq + 4 * hi;
      uint2 gw = *(const uint2*)(gp + d);
      f32x4 v;
#pragma unroll
      for (int i = 0; i < 4; ++i) v[i] = (dt == 0 ? o0[rq * 4 + i] : o1[rq * 4 + i]) * inv;
      v[0] *= __uint_as_float(gw.x << 16); v[1] *= __uint_as_float(gw.x & 0xffff0000u); v[2] *= __uint_as_float(gw.y << 16); v[3] *= __uint_as_float(gw.y & 0xffff0000u);
      if (do_store) st4bf(qp + d, v);
    }
}
DI void phase_attn(const Params& p, int l, LAS unsigned char* lds, int which) {
  const int wave = __builtin_amdgcn_readfirstlane(opaque_tid() >> 6);
  for (int u = (which == 0 ? 0 : 512) + blockIdx.x; u < (which == 0 ? 512 : 512 * 3); u += gridDim.x) {
    const int mode = u / 512, v = u % 512, rnd = v >> 8, c = v & 255;
    const int bhh = c & 31, g = rnd == 0 ? 15 - (c >> 5) : (c >> 5);
    const int b = bhh >> 3, h = bhh & 7, qblk = g * 8 + wave;
    if (mode == 0) { for (int r = 0; r < ATT_REP_A; ++r) attn_A_wg(p, b, h, g, lds, r == ATT_REP_A - 1); }
    else if (mode == 1) { for (int r = 0; r < ATT_REP_B; ++r) attn_wave<1>(p, l, b, h, qblk, r == ATT_REP_B - 1); }
    else { for (int r = 0; r < ATT_REP_C; ++r) attn_wave<2>(p, l, b, h, qblk, r == ATT_REP_C - 1); }
  }
}

DI void phase_final(const Params& p) {
  const int tid_ = opaque_tid(), lane = tid_ & 63, wave = __builtin_amdgcn_readfirstlane(tid_ >> 6);
  for (int row0 = (blockIdx.x * 8 + wave) * 4; row0 < NTOK; row0 += gridDim.x * 32) {
    f32x4 v[4][4]; float ss[4] = {0.f, 0.f, 0.f, 0.f};
#pragma unroll
    for (int r = 0; r < 4; ++r)
#pragma unroll
      for (int i = 0; i < 4; ++i) v[r][i] = *(const f32x4*)(p.out + (size_t)(row0 + r) * 1024 + i * 256 + lane * 4);
    f32x4 gg[4];
#pragma unroll
    for (int i = 0; i < 4; ++i) gg[i] = *(const f32x4*)(p.final_g + i * 256 + lane * 4);
#pragma unroll
    for (int r = 0; r < 4; ++r) {
#pragma unroll
      for (int i = 0; i < 4; ++i) ss[r] += v[r][i][0] * v[r][i][0] + v[r][i][1] * v[r][i][1] + v[r][i][2] * v[r][i][2] + v[r][i][3] * v[r][i][3];
      ss[r] = wave_sum(ss[r]);
    }
#pragma unroll
    for (int i = 0; i < 4; ++i) {
      int col = i * 256 + lane * 4; const f32x4 g = gg[i];
#pragma unroll
      for (int r = 0; r < 4; ++r) { const float rstd = rsqrtf(ss[r] * (1.0f / 1024.0f) + 1e-6f); *(f32x4*)(p.out + (size_t)(row0 + r) * 1024 + col) = v[r][i] * rstd * g; }
    }
  }
}

#define XB_TMO      128
#define XB_XCNT(j)  (256  + 64 * (j))
#define XB_XSUB(j)  (1280 + 64 * (j))
#define XB_XGEN(j)  (2304 + 64 * (j))
#define XB_TOP      3328
#define XB_TOPGEN   3392
#define XCD_BAR_WORDS 3456
#define XB_SPIN_CAP (1u << 18)
DI unsigned xb_ld(unsigned* p) { return __hip_atomic_load(p, __ATOMIC_RELAXED, __HIP_MEMORY_SCOPE_AGENT); }
DI unsigned xb_add(unsigned* p, unsigned v) { return __hip_atomic_fetch_add(p, v, __ATOMIC_RELAXED, __HIP_MEMORY_SCOPE_AGENT); }
DI unsigned xb_xcc_id() { return (unsigned)__builtin_amdgcn_s_getreg((3 << 11) | 20) & 0xFu; }
#define XB_SPIN(cond, bar) do { unsigned _sp = 0; while (cond) { __builtin_amdgcn_s_sleep(1); \
    if ((++_sp & 255u) == 0u) { if (xb_ld(&(bar)[XB_TMO])) break; if (_sp > XB_SPIN_CAP) { atomicAdd(&(bar)[XB_TMO], 1u); break; } } } } while (0)
struct XcdBarrier { unsigned* bar; unsigned x; volatile LAS unsigned* st; };
DI XcdBarrier xcd_barrier_post(unsigned* bar, volatile LAS unsigned* st) {
  XcdBarrier b; b.bar = bar; b.x = xb_xcc_id(); b.st = st;
  if (threadIdx.x == 0) (void)xb_add(&bar[XB_XCNT(b.x)], 1u);
  return b;
}
DI void xcd_barrier_complete(unsigned* bar, unsigned x, unsigned& nloc, unsigned& nx) {
  const unsigned G = gridDim.x * gridDim.y * gridDim.z;
  unsigned sum, cnt, mine, sp = 0u;
  for (;;) {
    sum = 0u; cnt = 0u; mine = 0u;
#pragma unroll
    for (unsigned j = 0; j < 16; ++j) { const unsigned c = xb_ld(&bar[XB_XCNT(j)]); sum += c; cnt += (c > 0u) ? 1u : 0u; mine = (j == x) ? c : mine; }
    if (sum == G) break;
    __builtin_amdgcn_s_sleep(1);
    if ((++sp & 255u) == 0u) { if (xb_ld(&bar[XB_TMO])) break; if (sp > XB_SPIN_CAP) { atomicAdd(&bar[XB_TMO], 1u); break; } }
  }
  nloc = mine > 0u ? mine : 1u; nx = cnt > 0u ? cnt : 1u;
}
DI void xcd_barrier(const XcdBarrier& b) {
  asm volatile("s_waitcnt vmcnt(0)" ::: "memory");
  __syncthreads();
  if (threadIdx.x == 0) {
    unsigned* bar = b.bar;
    __builtin_amdgcn_s_waitcnt(0);
    unsigned nloc = b.st[0], nx = b.st[1];
    if (nloc == 0u) { xcd_barrier_complete(bar, b.x, nloc, nx); b.st[0] = nloc; b.st[1] = nx; }
    const unsigned old = xb_add(&bar[XB_XSUB(b.x)], 1u);
    const unsigned gen = old / nloc;
    if (old + 1u == (gen + 1u) * nloc) {
      __builtin_amdgcn_fence(__ATOMIC_RELEASE, "agent");
      asm volatile("s_waitcnt vmcnt(0)" ::: "memory");
      const unsigned og = xb_add(&bar[XB_TOP], 1u);
      const unsigned tg = og / nx;
      if (og + 1u == (tg + 1u) * nx) xb_add(&bar[XB_TOPGEN], 1u);
      else XB_SPIN(xb_ld(&bar[XB_TOPGEN]) == tg, bar);
      __builtin_amdgcn_fence(__ATOMIC_ACQUIRE, "agent");
      xb_add(&bar[XB_XGEN(b.x)], 1u);
      asm volatile("s_waitcnt vmcnt(0)" ::: "memory");
    } else {
      XB_SPIN(xb_ld(&bar[XB_XGEN(b.x)]) == gen, bar);
      __builtin_amdgcn_fence(__ATOMIC_ACQUIRE, "agent");
      asm volatile("s_waitcnt vmcnt(0)" ::: "memory");
    }
  }
  __syncthreads();
}

struct KArgs { const float* in[12]; float* out; char* ws; };
constexpr size_t MiB = 1 << 20;
constexpr size_t OFF_ROPE = 0, OFF_MOD = OFF_ROPE + 1 * MiB, OFF_U = OFF_MOD + 98304, OFF_WTIN = OFF_U + 32 * MiB, OFF_WTBR = OFF_WTIN + (size_t)WT_IN_ROWS * 2048,
  OFF_WTOUT = OFF_WTBR + 3 * MiB, OFF_ZA = OFF_WTOUT + 2 * MiB, OFF_ZB = OFF_ZA + 64 * MiB, OFF_ZC = OFF_ZB + 40 * MiB, OFF_IQ = OFF_ZC + 64 * MiB, OFF_IK = OFF_IQ + 8 * MiB,
  OFF_IW = OFF_IK + 2 * MiB, OFF_BM = OFF_IW + (size_t)NTOK * 16, OFF_BAR = OFF_BM + 8 * MiB, OFF_END = OFF_BAR + 16384;
#define TPM(t) ((((t) & 7) << 3) + ((t) >> 5))
#define TPN(t) (((t) >> 3) & 3)
DI GemmTile main_tile(const char* wsb, int t) {
  const bool is_idx = t < 128; const int tt = is_idx ? t : t - 128;
  const int pn = is_idx ? (tt & 1) : (tt / 64), pm = is_idx ? (tt >> 1) : (tt % 64);
  GemmTile g; g.A = (const bf16_t*)(wsb + OFF_U); g.Bt = (const bf16_t*)(wsb + OFF_WTIN + (is_idx ? (size_t)COL_IDX * 2048 : (size_t)0)); g.K = 1024; g.brow = pm * 256; g.bcol = pn * 256; return g;
}
DI GemmTile merged_tile(const char* wsb, int t, int st) {
  const int pm = TPM(t), pn = TPN(t), x = st >> 1, kind = st & 1;
  const size_t aoff = kind == 0 ? OFF_U : (x == 0 ? OFF_ZA : (x == 1 ? OFF_ZB : OFF_ZB + 16 * MiB));
  const size_t boff = kind == 0 ? OFF_WTIN + (size_t)(COL_GATE + x * 1024) * 2048 : OFF_WTBR + (size_t)x * 1024 * 1024;
  GemmTile g; g.A = (const bf16_t*)(wsb + aoff); g.Bt = (const bf16_t*)(wsb + boff);
  g.K = kind == 0 ? 1024 : 512; g.brow = pm * 256; g.bcol = pn * 256; return g;
}
DI GemmTile out_tile(const char* wsb, int t) { GemmTile g; g.A = (const bf16_t*)(wsb + OFF_ZA + 16 * MiB); g.Bt = (const bf16_t*)(wsb + OFF_WTOUT); g.K = 1024; g.brow = TPM(t) * 256; g.bcol = TPN(t) * 256; return g; }
DI void run_phase(const Params& p, int ph, char* lds) {
  LAS unsigned char* shm = (LAS unsigned char*)lds;
  if (ph == 0) { phase_prep(p, lds); return; }
  if (ph == 15) { phase_final(p); return; }
  const int l = (ph - 1) / 7, sub = (ph - 1) % 7;
  const float* xin = l == 0 ? p.x : p.out;
  const char* wsb = (const char*)p.rope;
  if (sub == 0) { phase_a(p, l, xin, lds); }
  else if (sub == 1) {
    const int NTL = 128 + 64 * 21;
    if ((int)blockIdx.x < NTL) gemm_prologue(main_tile(wsb, blockIdx.x), shm);
    for (int t = blockIdx.x; t < NTL; t += gridDim.x) {
      const bool is_idx = t < 128;
      const int tt = is_idx ? t : t - 128;
      const int pn = is_idx ? (tt & 1) : (tt / 64), pm = is_idx ? (tt >> 1) : (tt % 64);
      const int tn = t + gridDim.x; const bool hn = tn < NTL;
      gemm256<true>(main_tile(wsb, t), hn, main_tile(wsb, hn ? tn : t), shm, [=](int ai, int bj, int m, f32x4 v0, f32x4 v1, int tid, int wr, int wc, int fr, int fq) {
        const int row = pm * 256 + ai * 128 + wr * 64 + m * 16 + fr; const int G = (pn * 256 + bj * 128 + wc * 32) >> 6;
        if (is_idx) epi_idx(p, row, G, (wc & 1) * 16 + fq * 4, v0, v1); else epi_main(p, row, G, (wc & 1) * 16 + fq * 4, v0, v1); });
    }
  }
  else if (sub == 2) { phase_attn(p, l, shm, 1); }
  else if (sub == 3) { phase_score_select(p); }
  else if (sub == 4) { phase_attn(p, l, shm, 0); }
  else if (sub == 5) {
    uint2* scr = (uint2*)(p.sigscr + (size_t)blockIdx.x * 65536);
    if ((int)blockIdx.x < 256) gemm_prologue(merged_tile(wsb, blockIdx.x, 0), shm);
    for (int t = blockIdx.x; t < 256; t += gridDim.x) {
      const int pm = TPM(t), pn = TPN(t);
#pragma unroll 1
      for (int st = 0; st < 6; ++st) {
        const int x = st >> 1, kind = st & 1;
        const bool lastst = st == 5; const int tn = lastst ? t + (int)gridDim.x : t; const bool hn = tn < 256;
        gemm256<false>(merged_tile(wsb, t, st), hn, merged_tile(wsb, hn ? tn : t, lastst ? 0 : st + 1), shm, [=](int ai, int bj, const f32x4 (&a)[4][2], int tid, int wr, int wc, int fr, int fq) {
          const int idx0 = (ai * 2 + bj) * 4;
          const int row0 = pm * 256 + ai * 128 + wr * 64 + fr; const int col = pn * 256 + bj * 128 + wc * 32 + fq * 4;
          if (kind == 0) {
#pragma unroll
            for (int m = 0; m < 4; ++m) {
              f32x4 s0, s1;
              for (int j = 0; j < 4; ++j) { s0[j] = fsigmoid(a[m][0][j]); s1[j] = fsigmoid(a[m][1][j]); }
              uint2 w0, w1; w0.x = pk2(s0[0], s0[1]); w0.y = pk2(s0[2], s0[3]); w1.x = pk2(s1[0], s1[1]); w1.y = pk2(s1[2], s1[3]);
              scr[((idx0 + m) * 2 + 0) * 512 + tid] = w0; scr[((idx0 + m) * 2 + 1) * 512 + tid] = w1;
            }
          } else {
#pragma unroll
            for (int mh = 0; mh < 4; mh += 2) {
              uint2 g0[2], g1[2], o0[2], o1[2];
#pragma unroll
              for (int m = 0; m < 2; ++m) { g0[m] = scr[((idx0 + mh + m) * 2 + 0) * 512 + tid]; g1[m] = scr[((idx0 + mh + m) * 2 + 1) * 512 + tid]; }
              if (x > 0) {
#pragma unroll
                for (int m = 0; m < 2; ++m) { const bf16_t* mp = p.merged + (size_t)(row0 + (mh + m) * 16) * 1024 + col; o0[m] = *(const uint2*)mp; o1[m] = *(const uint2*)(mp + 16); }
              }
#pragma unroll
              for (int m = 0; m < 2; ++m) {
                f32x4 v0 = a[mh + m][0], v1 = a[mh + m][1];
                const f32x4 s0 = {__uint_as_float(g0[m].x << 16), __uint_as_float(g0[m].x & 0xffff0000u), __uint_as_float(g0[m].y << 16), __uint_as_float(g0[m].y & 0xffff0000u)};
                const f32x4 s1 = {__uint_as_float(g1[m].x << 16), __uint_as_float(g1[m].x & 0xffff0000u), __uint_as_float(g1[m].y << 16), __uint_as_float(g1[m].y & 0xffff0000u)};
                v0 *= s0; v1 *= s1;
                if (x > 0) {
                  v0[0] += __uint_as_float(o0[m].x << 16); v0[1] += __uint_as_float(o0[m].x & 0xffff0000u); v0[2] += __uint_as_float(o0[m].y << 16); v0[3] += __uint_as_float(o0[m].y & 0xffff0000u);
                  v1[0] += __uint_as_float(o1[m].x << 16); v1[1] += __uint_as_float(o1[m].x & 0xffff0000u); v1[2] += __uint_as_float(o1[m].y << 16); v1[3] += __uint_as_float(o1[m].y & 0xffff0000u);
                }
                bf16_t* mp = p.merged + (size_t)(row0 + (mh + m) * 16) * 1024 + col;
                st4bf(mp, v0); st4bf(mp + 16, v1);
              }
              __builtin_amdgcn_sched_barrier(0);
            }
          } });
      }
    }
  }
  else {
    if ((int)blockIdx.x < 256) gemm_prologue(out_tile(wsb, blockIdx.x), shm);
    for (int t = blockIdx.x; t < 256; t += gridDim.x) {
      const int pm = TPM(t), pn = TPN(t);
      const int tn = t + gridDim.x; const bool hn = tn < 256;
      gemm256<false>(out_tile(wsb, t), hn, out_tile(wsb, hn ? tn : t), shm, [=](int ai, int bj, const f32x4 (&a)[4][2], int tid, int wr, int wc, int fr, int fq) {
        const int row0 = pm * 256 + ai * 128 + wr * 64 + fr; const int col = pn * 256 + bj * 128 + wc * 32 + fq * 4;
        const int b = row0 >> 12; const float* gt = p.mod + (l * 4 + b) * 3072 + 2048 + col;
#pragma unroll
        for (int mh = 0; mh < 4; mh += 2) {
          const f32x4 g0 = *(const f32x4*)gt, g1 = *(const f32x4*)(gt + 16);
          f32x4 x0[2], x1[2];
#pragma unroll
          for (int m = 0; m < 2; ++m) { const float* xi = xin + (size_t)(row0 + (mh + m) * 16) * 1024 + col; x0[m] = *(const f32x4*)xi; x1[m] = *(const f32x4*)(xi + 16); }
#pragma unroll
          for (int m = 0; m < 2; ++m) { float* xo = p.out + (size_t)(row0 + (mh + m) * 16) * 1024 + col; *(f32x4*)xo = x0[m] + g0 * a[mh + m][0]; *(f32x4*)(xo + 16) = x1[m] + g1 * a[mh + m][1]; }
          __builtin_amdgcn_sched_barrier(0);
        } });
    }
  }
}

DI Params make_params(const KArgs& k, char* w) {
  Params p;
  p.x = k.in[0]; p.c = k.in[1]; p.norm_g = k.in[2]; p.w_ada = k.in[3]; p.b_ada = k.in[4]; p.w_in = k.in[5]; p.sinks = k.in[6];
  p.w_br_a = k.in[7]; p.w_br_b = k.in[8]; p.w_br_c = k.in[9]; p.w_out = k.in[10]; p.final_g = k.in[11]; p.out = k.out;
  p.rope = (float2*)(w + OFF_ROPE); p.mod = (float*)(w + OFF_MOD); p.u = (bf16_t*)(w + OFF_U); p.wt_in = (bf16_t*)(w + OFF_WTIN); p.wt_br = (bf16_t*)(w + OFF_WTBR); p.wt_out = (bf16_t*)(w + OFF_WTOUT);
  p.zAq = (bf16_t*)(w + OFF_ZA); p.zAk = (bf16_t*)(w + OFF_ZA + 16 * MiB); p.zAv = (bf16_t*)(w + OFF_ZA + 32 * MiB); p.zAg = (bf16_t*)(w + OFF_ZA + 48 * MiB);
  p.zBq = (bf16_t*)(w + OFF_ZB); p.zCq = (bf16_t*)(w + OFF_ZB + 16 * MiB); p.zBk = (bf16_t*)(w + OFF_ZB + 32 * MiB); p.zBv = (bf16_t*)(w + OFF_ZB + 36 * MiB); p.zBg = (bf16_t*)(w + OFF_ZB + 40 * MiB);
  p.zCk = (bf16_t*)(w + OFF_ZB + 56 * MiB); p.zCv = (bf16_t*)(w + OFF_ZB + 72 * MiB); p.zCg = (bf16_t*)(w + OFF_ZB + 88 * MiB);
  p.iq = (bf16_t*)(w + OFF_IQ); p.ik = (bf16_t*)(w + OFF_IK); p.iw = (float*)(w + OFF_IW); p.bitmask = (unsigned*)(w + OFF_BM);
  p.sscr = (float*)p.zBk; p.merged = p.zAk; p.sigscr = p.zCk;
  return p;
}
template <bool COOP, int ONLY>
__global__ void __launch_bounds__(512) mega(KArgs ka, int ph_lo, int ph_hi) {
  extern __shared__ __attribute__((aligned(16))) char lds[];
  bool rep = false;
  XcdBarrier xb;
  if (COOP) {
    volatile LAS unsigned* st = (volatile LAS unsigned*)((LAS unsigned char*)lds + 131072);
    if (threadIdx.x < 4) st[threadIdx.x] = 0u;
    __syncthreads();
    xb = xcd_barrier_post((unsigned*)(ka.ws + OFF_BAR), st);
    if (ph_hi > 1000) cg::this_grid().sync();
  }
  for (int ph = ph_lo; ph < ph_hi; ++ph) {
    if (ONLY >= 0) { const int kind = (ph == 0) ? 7 : (ph == 15 ? 8 : (ph - 1) % 7); if (kind != ONLY) continue; }
    __attribute__((address_space(1))) char* wsp = (__attribute__((address_space(1))) char*)ka.ws; asm volatile("" : "+s"(wsp));
    const Params p = make_params(ka, (char*)wsp);
    run_phase(p, ph, lds);
    if (COOP && ph + 1 < ph_hi) { xcd_barrier(xb); }
    if (REP_HI >= 0 && ph >= 1 && ph < 15 && (ph - 1) % 7 == REP_HI) { if (!rep) { rep = true; ph -= (REP_HI - REP_LO + 1); } else rep = false; }
  }
}

extern "C" void kernel_launch(void* const* d_in, const int* in_sizes, int n_in, void* d_out, int out_size, void* d_ws, size_t ws_size, hipStream_t stream) {
  KArgs p{};
  for (int i = 0; i < 12; ++i) p.in[i] = (const float*)d_in[i];
  p.out = (float*)d_out; p.ws = (char*)d_ws;
  if (OFF_END > ws_size) { fprintf(stderr, "workspace too small: need %zu have %zu\n", (size_t)OFF_END, ws_size); return; }
#if USE_COOP
  (void)hipFuncSetAttribute((const void*)mega<true, -1>, hipFuncAttributeMaxDynamicSharedMemorySize, LDS_BYTES);
  (void)hipMemsetAsync((char*)d_ws + OFF_BAR, 0, 16384, stream);
  int lo = 0, hi = 16; void* args[] = {&p, &lo, &hi};
  hipError_t e = hipLaunchCooperativeKernel((void*)mega<true, -1>, dim3(256), dim3(512), args, LDS_BYTES, stream);
  if (e != hipSuccess) fprintf(stderr, "cooperative launch failed: %s\n", hipGetErrorString(e));
#else
#define LAUNCH_KIND(KD, ph) do { (void)hipFuncSetAttribute((const void*)mega<false, KD>, hipFuncAttributeMaxDynamicSharedMemorySize, LDS_BYTES); \
    hipLaunchKernelGGL((mega<false, KD>), dim3(256), dim3(512), LDS_BYTES, stream, p, ph, ph + 1); } while (0)
  LAUNCH_KIND(7, 0);
  for (int l = 0; l < 2; ++l) { const int b = 1 + 7 * l;
    LAUNCH_KIND(0, b); LAUNCH_KIND(1, b + 1); LAUNCH_KIND(2, b + 2); LAUNCH_KIND(3, b + 3); LAUNCH_KIND(4, b + 4); LAUNCH_KIND(5, b + 5); LAUNCH_KIND(6, b + 6); }
  LAUNCH_KIND(8, 15);
#endif
}
```
